# Optimizing an MI355X kernel written in HIP

```python
import jax, jax.numpy as jnp
from jax import lax
import numpy as np

D_MODEL = 1024
BATCH = 16
SEQ = 2048
DEPTH = 4

HEAD_DIM = 64
D_CONV = 512
D_LRU = 512
N_CONV_GROUPS = D_CONV // HEAD_DIM
N_LRU_HEADS = D_LRU // HEAD_DIM
D_MIX = D_CONV + D_LRU
D_IN = 3 * D_CONV + 2 * D_LRU
CONV_A_WIDTH = 3
CONV_B_WIDTH = 4
LRU_C = 8.0
D_FF = 3072
N_EXPERTS = 8
TOP_K = 2
D_FF_EXPERT = 3584
MOE_BLOCK = 128
N_DENSE = (DEPTH + 1) // 2
N_MOE = DEPTH // 2
EPS = 1e-6

kernel_name = "hymba_conv_rglru_moe_trunk"


def rms_norm(x, g):
    x32 = x.astype(jnp.float32)
    y = x32 * lax.rsqrt(jnp.mean(x32 * x32, axis=-1, keepdims=True) + EPS)
    return (y * g.astype(jnp.float32)).astype(x.dtype)


def group_rms_norm(x, g, group):
    b, s, d = x.shape
    xg = x.astype(jnp.float32).reshape(b, s, d // group, group)
    xg = xg * lax.rsqrt(jnp.mean(xg * xg, axis=-1, keepdims=True) + EPS)
    return (xg.reshape(b, s, d) * g.astype(jnp.float32)).astype(x.dtype)


def causal_depthwise_conv(u, w, bias):
    k, c = w.shape
    y = lax.conv_general_dilated(
        u, w[:, None, :].astype(u.dtype), window_strides=(1,), padding=[(k - 1, 0)],
        dimension_numbers=("NWC", "WIO", "NWC"), feature_group_count=c)
    return y + bias.astype(u.dtype)


def rg_lru(x, w_r, b_r, w_i, b_i, lam):
    b, s, d = x.shape
    x32 = x.astype(jnp.float32)
    xh = x32.reshape(b, s, N_LRU_HEADS, HEAD_DIM)
    r = jax.nn.sigmoid(jnp.einsum("bshd,hde->bshe", xh, w_r.astype(jnp.float32)).reshape(b, s, d)
                       + b_r.astype(jnp.float32))
    i = jax.nn.sigmoid(jnp.einsum("bshd,hde->bshe", xh, w_i.astype(jnp.float32)).reshape(b, s, d)
                       + b_i.astype(jnp.float32))
    log_a = -LRU_C * r * jax.nn.softplus(-lam.astype(jnp.float32))
    a = jnp.exp(log_a)
    u = jnp.sqrt(-jnp.expm1(2.0 * log_a)) * (i * x32)

    def combine(left, right):
        a1, b1 = left
        a2, b2 = right
        return a1 * a2, a2 * b1 + b2

    _, h = lax.associative_scan(combine, (a, u), axis=1)
    return h.astype(x.dtype)


def hybrid_mixer(xn, w_in, conv_a_w, conv_a_b, conv_b_w, conv_b_b,
                 w_r, b_r, w_i, b_i, lam, g_mix, w_out):
    z = jnp.einsum("bsd,de->bse", xn, w_in)
    xa, gb, gc, xr, gr = jnp.split(
        z, [D_CONV, 2 * D_CONV, 3 * D_CONV, 3 * D_CONV + D_LRU], axis=-1)
    ya = gb * causal_depthwise_conv(gc * xa, conv_a_w, conv_a_b)
    yr = rg_lru(causal_depthwise_conv(xr, conv_b_w, conv_b_b), w_r, b_r, w_i, b_i, lam) * jax.nn.gelu(gr)
    y = jnp.concatenate([ya, yr], axis=-1)
    y = group_rms_norm(y, g_mix, HEAD_DIM)
    return jnp.einsum("bse,ed->bsd", y, w_out)


def swiglu(x, w1, w3, w2):
    h = jax.nn.silu(jnp.einsum("bsd,df->bsf", x, w1)) * jnp.einsum("bsd,df->bsf", x, w3)
    return jnp.einsum("bsf,fd->bsd", h, w2)


def moe_swiglu(x, w_router, w1, w3, w2):
    b, s, d = x.shape
    t = b * s
    xf = x.reshape(t, d)
    logits = jnp.einsum("td,de->te", xf.astype(jnp.float32), w_router.astype(jnp.float32))
    top_vals, top_idx = lax.top_k(logits, TOP_K)
    gates = jax.nn.softmax(top_vals, axis=-1)
    n_assign = t * TOP_K
    expert_ids = top_idx.reshape(-1).astype(jnp.int32)
    token_ids = jnp.arange(n_assign, dtype=jnp.int32) // TOP_K
    gate_flat = gates.reshape(-1)
    order = jnp.argsort(expert_ids)
    sorted_e = expert_ids[order]
    counts = jnp.bincount(expert_ids, length=N_EXPERTS)
    padded = (counts + MOE_BLOCK - 1) // MOE_BLOCK * MOE_BLOCK
    start = jnp.cumsum(counts) - counts
    pad_end = jnp.cumsum(padded)
    pad_start = pad_end - padded
    rank = jnp.arange(n_assign, dtype=jnp.int32) - start[sorted_e]
    dest = pad_start[sorted_e] + rank
    n_blocks = -(-n_assign // MOE_BLOCK) + N_EXPERTS
    cap = n_blocks * MOE_BLOCK
    buf_tok = jnp.zeros((cap,), jnp.int32).at[dest].set(token_ids[order])
    buf_gate = jnp.zeros((cap,), jnp.float32).at[dest].set(gate_flat[order])
    block_start = jnp.arange(n_blocks, dtype=jnp.int32) * MOE_BLOCK
    block_expert = jnp.minimum(jnp.searchsorted(pad_end, block_start, side="right"), N_EXPERTS - 1)
    xb = xf[buf_tok].reshape(n_blocks, MOE_BLOCK, d)

    def expert_block(args):
        xblk, e = args
        h = jax.nn.silu(xblk @ w1[e]) * (xblk @ w3[e])
        return h @ w2[e]

    yb = lax.map(expert_block, (xb, block_expert)).reshape(cap, d)
    yb = yb * buf_gate[:, None].astype(yb.dtype)
    out = jnp.zeros((t, d), x.dtype).at[buf_tok].add(yb.astype(x.dtype))
    return out.reshape(b, s, d)


def setup_inputs(seed: int = 0) -> dict:
    key = jax.random.key(seed)
    ks = jax.random.split(key, 24)
    f32 = jnp.float32

    def nrm(k, shape, fan_in):
        return jax.random.normal(k, shape, f32) * (fan_in ** -0.5)

    def gain(k, shape):
        return 1.0 + 0.05 * jax.random.normal(k, shape, f32)

    def small(k, shape):
        return 0.02 * jax.random.normal(k, shape, f32)

    u = jax.random.uniform(ks[10], (DEPTH, D_LRU), f32, 0.9, 0.999)
    s_root = u ** (1.0 / LRU_C)
    lam = jnp.log(s_root) - jnp.log1p(-s_root)
    return {
        "x": jax.random.normal(ks[0], (BATCH, SEQ, D_MODEL), f32),
        "norm_mix_g": gain(ks[1], (DEPTH, D_MODEL)),
        "w_in": nrm(ks[2], (DEPTH, D_MODEL, D_IN), D_MODEL),
        "conv_a_w": nrm(ks[3], (DEPTH, CONV_A_WIDTH, D_CONV), CONV_A_WIDTH),
        "conv_a_b": small(ks[4], (DEPTH, D_CONV)),
        "conv_b_w": nrm(ks[5], (DEPTH, CONV_B_WIDTH, D_LRU), CONV_B_WIDTH),
        "conv_b_b": small(ks[6], (DEPTH, D_LRU)),
        "lru_w_r": nrm(ks[7], (DEPTH, N_LRU_HEADS, HEAD_DIM, HEAD_DIM), HEAD_DIM),
        "lru_b_r": small(ks[8], (DEPTH, D_LRU)),
        "lru_w_i": nrm(ks[9], (DEPTH, N_LRU_HEADS, HEAD_DIM, HEAD_DIM), HEAD_DIM),
        "lru_b_i": small(ks[11], (DEPTH, D_LRU)),
        "lru_lambda": lam,
        "mix_out_g": gain(ks[12], (DEPTH, D_MIX)),
        "w_out": nrm(ks[13], (DEPTH, D_MIX, D_MODEL), D_MIX),
        "norm_ffn_g": gain(ks[14], (DEPTH, D_MODEL)),
        "ffn_w1": nrm(ks[15], (N_DENSE, D_MODEL, D_FF), D_MODEL),
        "ffn_w3": nrm(ks[16], (N_DENSE, D_MODEL, D_FF), D_MODEL),
        "ffn_w2": nrm(ks[17], (N_DENSE, D_FF, D_MODEL), D_FF),
        "router_w": nrm(ks[18], (N_MOE, D_MODEL, N_EXPERTS), D_MODEL),
        "expert_w1": nrm(ks[19], (N_MOE, N_EXPERTS, D_MODEL, D_FF_EXPERT), D_MODEL),
        "expert_w3": nrm(ks[20], (N_MOE, N_EXPERTS, D_MODEL, D_FF_EXPERT), D_MODEL),
        "expert_w2": nrm(ks[21], (N_MOE, N_EXPERTS, D_FF_EXPERT, D_MODEL), D_FF_EXPERT),
        "final_g": gain(ks[22], (D_MODEL,)),
    }


def reference(x, norm_mix_g, w_in, conv_a_w, conv_a_b, conv_b_w, conv_b_b,
              lru_w_r, lru_b_r, lru_w_i, lru_b_i, lru_lambda, mix_out_g, w_out,
              norm_ffn_g, ffn_w1, ffn_w3, ffn_w2, router_w, expert_w1, expert_w3,
              expert_w2, final_g):
    h = x
    for layer in range(DEPTH):
        hn = rms_norm(h, norm_mix_g[layer])
        h = h + hybrid_mixer(hn, w_in[layer], conv_a_w[layer], conv_a_b[layer],
                             conv_b_w[layer], conv_b_b[layer], lru_w_r[layer], lru_b_r[layer],
                             lru_w_i[layer], lru_b_i[layer], lru_lambda[layer],
                             mix_out_g[layer], w_out[layer])
        hn = rms_norm(h, norm_ffn_g[layer])
        j = layer // 2
        if layer % 2 == 0:
            h = h + swiglu(hn, ffn_w1[j], ffn_w3[j], ffn_w2[j])
        else:
            h = h + moe_swiglu(hn, router_w[j], expert_w1[j], expert_w3[j], expert_w2[j])
    return rms_norm(h, final_g)
```

```cpp
#include <hip/hip_runtime.h>
#include <cstdio>
#include <cstdint>

#ifndef DBG_MASK
#define DBG_MASK 0xFFFF
#endif
#define DBG_ON(b) ((DBG_MASK >> (b)) & 1)
#ifndef REP_MASK
#define REP_MASK 0
#endif
#ifndef MK_MULTI
#define MK_MULTI 0
#endif

namespace pg8 {
#define PG8_LAS __attribute__((address_space(3)))
typedef unsigned short bf16_t;
typedef short bf16x8 __attribute__((ext_vector_type(8)));
typedef float f32x4 __attribute__((ext_vector_type(4)));
typedef unsigned u32x4 __attribute__((ext_vector_type(4)));
constexpr int BM = 256, BK = 64, HALF = 128, HTB = HALF * BK * 2  , STAGE_BYTES = 8 * HTB, NXCD = 8, WGM = 8;
constexpr float RMS_EPS = 1e-6f;
typedef unsigned long long u64;
__device__ __forceinline__ u64 ss_to_fx(float ss) { return (u64)(ss * 1048576.0f + 0.5f); }
__device__ __forceinline__ float fx_to_rs(u64 v) { return __builtin_amdgcn_rsqf((float)v * (1.0f / (1048576.0f * 1024.0f)) + RMS_EPS); }

__host__ __device__ __forceinline__ int lds_byte(int r, int c) { const int st = (r >> 4) * 2 + (c >> 5), rr = r & 15, cc = c & 31, ob = rr * 64 + cc * 2; return st * 1024 + (ob ^ (((ob >> 9) & 1) << 5)); }
__host__ __device__ __forceinline__ void stage_rc(int b, int& R, int& C) { const int st = b / 1024, sb = b % 1024, swz = sb ^ (((sb >> 9) & 1) << 5); R = (st >> 1) * 16 + swz / 64; C = (st & 1) * 32 + (swz % 64) / 2; }
__host__ __device__ __forceinline__ int perm32(int rho) { const int n = rho >> 4, i = rho & 15; return 8 * (i >> 2) + 4 * n + (i & 3); }

struct Unit { int pm, pn; };
struct Gemm { const void* A; const void* Bt; int pitch; int sa, sb; };
typedef int i32x4 __attribute__((ext_vector_type(4)));
typedef int i32x8 __attribute__((ext_vector_type(8)));

struct Sched {
    int nM, nN, nwg, G, c; int tend[8]; size_t estride; int pm0;
    __device__ __forceinline__ void init(int nM_, int nN_, int G_, int c_) { nM = nM_; nN = nN_; nwg = nM * nN; G = G_; c = c_; estride = 0; ecap = 0; pm0 = 0;
#pragma unroll
        for (int e = 0; e < 8; ++e) tend[e] = 0; }
    __device__ __forceinline__ bool next(int i, Unit& u) const {
        const long L = (long)i * G + c; if (L >= nwg) return false;
        int wgid = (int)L; { const int q = nwg / NXCD, r = nwg % NXCD, xcd = wgid % NXCD, off = wgid / NXCD; wgid = (xcd < r ? xcd * (q + 1) : r * (q + 1) + (xcd - r) * q) + off; }
        const int nig = WGM * nN, gid = wgid / nig, fm = gid * WGM, gsz = (nM - fm) < WGM ? (nM - fm) : WGM;
        u.pm = pm0 + fm + ((wgid % nig) % gsz); u.pn = (wgid % nig) / gsz; return true;
    }
    int ecap;
    __device__ __forceinline__ int arow(int pm) const { int e = 0, ts = 0;
#pragma unroll
        for (int k = 0; k < 7; ++k) if (pm >= tend[k]) { e = k + 1; ts = tend[k]; }
        return e * ecap + (pm - ts) * BM; }
    __device__ __forceinline__ int expert(int pm) const { int e = 0;
#pragma unroll
        for (int k = 0; k < 7; ++k) e += (pm >= tend[k]) ? 1 : 0;
        return e; }
};

__device__ __forceinline__ unsigned cvt_pk_bf16(float lo, float hi) { unsigned r; asm volatile("v_cvt_pk_bf16_f32 %0, %1, %2" : "=v"(r) : "v"(lo), "v"(hi)); return r; }

__device__ __forceinline__ unsigned pk4_fp8(float a, float b, float c, float d) {
    a = fminf(fmaxf(a, -448.f), 448.f); b = fminf(fmaxf(b, -448.f), 448.f); c = fminf(fmaxf(c, -448.f), 448.f); d = fminf(fmaxf(d, -448.f), 448.f);
    int w = 0; w = __builtin_amdgcn_cvt_pk_fp8_f32(a, b, w, false); w = __builtin_amdgcn_cvt_pk_fp8_f32(c, d, w, true); return (unsigned)w; }
__device__ __forceinline__ void row_scales8(const u64* sumsq, int row0, float (&rsv)[2][4]) {
    if (sumsq) {
        u64 raw[8];
#pragma unroll
        for (int k = 0; k < 8; ++k) { const u64* p = sumsq + row0 + (k >> 2) * HALF + (k & 3) * 16; asm volatile("global_load_dwordx2 %0, %1, off" : "=v"(raw[k]) : "v"(p)); }
        asm volatile("s_waitcnt vmcnt(0)" : "+v"(raw[0]), "+v"(raw[1]), "+v"(raw[2]), "+v"(raw[3]), "+v"(raw[4]), "+v"(raw[5]), "+v"(raw[6]), "+v"(raw[7]) :: "memory");
#pragma unroll
        for (int k = 0; k < 8; ++k) rsv[k >> 2][k & 3] = fx_to_rs(raw[k]);
    } else {
#pragma unroll
        for (int k = 0; k < 8; ++k) rsv[k >> 2][k & 3] = 1.0f;
    }
}
#define PG8_ZERO(ai, m) do { acc[ai][0][m][0] = (f32x4){0.f, 0.f, 0.f, 0.f}; acc[ai][0][m][1] = (f32x4){0.f, 0.f, 0.f, 0.f}; acc[ai][1][m][0] = (f32x4){0.f, 0.f, 0.f, 0.f}; acc[ai][1][m][1] = (f32x4){0.f, 0.f, 0.f, 0.f}; } while (0)
struct EpiScale {
    static constexpr bool PERM = true;
    bf16_t* O; int ldc; const u64* sumsq;
    __device__ __forceinline__ void operator()(f32x4 (&acc)[2][2][4][2], const Unit& u, int wr, int wc, int fr, int fq) const {
        const int row0 = u.pm * BM + wr * 64 + fr, col0 = u.pn * BM + wc * 32 + 8 * fq;
        float rsv[2][4]; row_scales8(sumsq, row0, rsv);
#pragma unroll
        for (int ai = 0; ai < 2; ++ai)
#pragma unroll
            for (int m = 0; m < 4; ++m) { const int row = row0 + ai * HALF + m * 16; bf16_t* rowp = O + (size_t)row * ldc + col0;
                const float rs = rsv[ai][m];
#pragma unroll
                for (int bj = 0; bj < 2; ++bj) { const f32x4 v0 = acc[ai][bj][m][0] * rs, v1 = acc[ai][bj][m][1] * rs;
                    u32x4 w; w.x = cvt_pk_bf16(v0[0], v0[1]); w.y = cvt_pk_bf16(v0[2], v0[3]); w.z = cvt_pk_bf16(v1[0], v1[1]); w.w = cvt_pk_bf16(v1[2], v1[3]);
                    *(u32x4*)(rowp + bj * HALF) = w; } PG8_ZERO(ai, m); }
    }
};
struct EpiMix {
    static constexpr bool PERM = true;
    bf16_t* O; int ldc; const u64* sumsq;
    __device__ __forceinline__ void operator()(f32x4 (&acc)[2][2][4][2], const Unit& u, int wr, int wc, int fr, int fq) const {
        const int row0 = u.pm * BM + wr * 64 + fr;
        float rsv[2][4]; row_scales8(sumsq, row0, rsv);
        if (u.pn < 4) {
            const int col0 = u.pn * HALF + wc * 32 + 8 * fq;
#pragma unroll
            for (int ai = 0; ai < 2; ++ai)
#pragma unroll
                for (int m = 0; m < 4; ++m) { const int row = row0 + ai * HALF + m * 16; const float r2 = rsv[ai][m] * rsv[ai][m];
                    const f32x4 v0 = acc[ai][0][m][0] * acc[ai][1][m][0] * r2, v1 = acc[ai][0][m][1] * acc[ai][1][m][1] * r2;
                    u32x4 w; w.x = cvt_pk_bf16(v0[0], v0[1]); w.y = cvt_pk_bf16(v0[2], v0[3]); w.z = cvt_pk_bf16(v1[0], v1[1]); w.w = cvt_pk_bf16(v1[2], v1[3]);
                    *(u32x4*)(O + (size_t)row * ldc + col0) = w; PG8_ZERO(ai, m); }
        } else {
            const int col0 = 512 + (u.pn - 4) * BM + wc * 32 + 8 * fq;
#pragma unroll
            for (int ai = 0; ai < 2; ++ai)
#pragma unroll
                for (int m = 0; m < 4; ++m) { const int row = row0 + ai * HALF + m * 16; bf16_t* rowp = O + (size_t)row * ldc + col0; const float rs = rsv[ai][m];
#pragma unroll
                    for (int bj = 0; bj < 2; ++bj) { f32x4 v0 = acc[ai][bj][m][0] * rs, v1 = acc[ai][bj][m][1] * rs;
                        if (u.pn >= 8) {
#pragma unroll
                            for (int q = 0; q < 4; ++q) { const float g0 = v0[q], g1 = v1[q];
                                v0[q] = g0 * __builtin_amdgcn_rcpf(1.0f + __builtin_amdgcn_exp2f(g0 * (-2.3022082f - 0.10294324f * g0 * g0)));
                                v1[q] = g1 * __builtin_amdgcn_rcpf(1.0f + __builtin_amdgcn_exp2f(g1 * (-2.3022082f - 0.10294324f * g1 * g1))); } }
                        u32x4 w; w.x = cvt_pk_bf16(v0[0], v0[1]); w.y = cvt_pk_bf16(v0[2], v0[3]); w.z = cvt_pk_bf16(v1[0], v1[1]); w.w = cvt_pk_bf16(v1[2], v1[3]);
                        *(u32x4*)(rowp + bj * HALF) = w; } PG8_ZERO(ai, m); }
        }
    }
};
struct EpiResid {
    static constexpr bool PERM = true;
    bf16_t* h; u64* sumsq; int mode; unsigned char* h8;
    __device__ __forceinline__ void operator()(f32x4 (&acc)[2][2][4][2], const Unit& u, int wr, int wc, int fr, int fq) const {
        typedef unsigned u32x2 __attribute__((ext_vector_type(2)));
        const int row0 = u.pm * BM + wr * 64 + fr, col0 = u.pn * BM + wc * 32 + 8 * fq;
#pragma unroll
        for (int ai = 0; ai < 2; ++ai) {
            u32x4 hw[4][2];
#pragma unroll
            for (int m = 0; m < 4; ++m)
#pragma unroll
                for (int bj = 0; bj < 2; ++bj) hw[m][bj] = *(const u32x4*)(h + (size_t)(row0 + ai * HALF + m * 16) * 1024 + col0 + bj * HALF);
#pragma unroll
            for (int m = 0; m < 4; ++m) { const int row = row0 + ai * HALF + m * 16; const size_t off = (size_t)row * 1024 + col0;
                float ss = 0.f;
#pragma unroll
                for (int bj = 0; bj < 2; ++bj) {
                    const u32x4 w0 = hw[m][bj];
                    f32x4 h0, h1;
                    h0[0] = __builtin_bit_cast(float, w0.x << 16); h0[1] = __builtin_bit_cast(float, w0.x & 0xffff0000u); h0[2] = __builtin_bit_cast(float, w0.y << 16); h0[3] = __builtin_bit_cast(float, w0.y & 0xffff0000u);
                    h1[0] = __builtin_bit_cast(float, w0.z << 16); h1[1] = __builtin_bit_cast(float, w0.z & 0xffff0000u); h1[2] = __builtin_bit_cast(float, w0.w << 16); h1[3] = __builtin_bit_cast(float, w0.w & 0xffff0000u);
                    h0 += acc[ai][bj][m][0]; h1 += acc[ai][bj][m][1];
                    u32x4 w; w.x = cvt_pk_bf16(h0[0], h0[1]); w.y = cvt_pk_bf16(h0[2], h0[3]); w.z = cvt_pk_bf16(h1[0], h1[1]); w.w = cvt_pk_bf16(h1[2], h1[3]);
                    *(u32x4*)(h + off + bj * HALF) = w;
                    if (mode) ss += (h0[0] * h0[0] + h0[1] * h0[1]) + (h0[2] * h0[2] + h0[3] * h0[3]) + (h1[0] * h1[0] + h1[1] * h1[1]) + (h1[2] * h1[2] + h1[3] * h1[3]);
                    if (mode == 2) { u32x2 w8; w8.x = pk4_fp8(h0[0] * 8.0f, h0[1] * 8.0f, h0[2] * 8.0f, h0[3] * 8.0f); w8.y = pk4_fp8(h1[0] * 8.0f, h1[1] * 8.0f, h1[2] * 8.0f, h1[3] * 8.0f);
                        *(u32x2*)(h8 + off + bj * HALF) = w8; }
                }
                if (mode) { ss += __shfl_xor(ss, 16); ss += __shfl_xor(ss, 32); if (fq == 0) atomicAdd(sumsq + row, ss_to_fx(ss)); }
                PG8_ZERO(ai, m);
            }
            asm volatile("" ::: "memory"); }
    }
};
struct EpiSwiglu {
    static constexpr bool PERM = true;
    bf16_t* O; int ldc; const u64* sumsq;
    __device__ __forceinline__ void operator()(f32x4 (&acc)[2][2][4][2], const Unit& u, int wr, int wc, int fr, int fq) const {
        const int row0 = u.pm * BM + wr * 64 + fr, col0 = u.pn * HALF + wc * 32 + 8 * fq;
        float rsv[2][4]; row_scales8(sumsq, row0, rsv);
#pragma unroll
        for (int ai = 0; ai < 2; ++ai)
#pragma unroll
            for (int m = 0; m < 4; ++m) { const int row = row0 + ai * HALF + m * 16;
                const float rs = rsv[ai][m];
                float o[8];
#pragma unroll
                for (int n = 0; n < 2; ++n)
#pragma unroll
                    for (int j = 0; j < 4; ++j) { const float a = acc[ai][0][m][n][j] * rs, b = acc[ai][1][m][n][j] * rs;
                        const float sg = __builtin_amdgcn_rcpf(1.0f + __builtin_amdgcn_exp2f(a * -1.4426950408889634f));
                        o[n * 4 + j] = a * sg * b; }
                u32x4 w; w.x = cvt_pk_bf16(o[0], o[1]); w.y = cvt_pk_bf16(o[2], o[3]); w.z = cvt_pk_bf16(o[4], o[5]); w.w = cvt_pk_bf16(o[6], o[7]);
                *(u32x4*)(O + (size_t)row * ldc + col0) = w; PG8_ZERO(ai, m); }
    }
};

struct EpiSwiglu8 {
    static constexpr bool PERM = true;
    unsigned char* O; int ldc; const u64* sumsq;
    __device__ __forceinline__ void operator()(f32x4 (&acc)[2][2][4][2], const Unit& u, int wr, int wc, int fr, int fq) const {
        typedef unsigned u32x2 __attribute__((ext_vector_type(2)));
        const int row0 = u.pm * BM + wr * 64 + fr, col0 = u.pn * HALF + wc * 32 + 8 * fq;
        float rsv[2][4]; row_scales8(sumsq, row0, rsv);
#pragma unroll
        for (int ai = 0; ai < 2; ++ai)
#pragma unroll
            for (int m = 0; m < 4; ++m) { const int row = row0 + ai * HALF + m * 16;
                const float rs = rsv[ai][m];
                float o[8];
#pragma unroll
                for (int n = 0; n < 2; ++n)
#pragma unroll
                    for (int j = 0; j < 4; ++j) { const float a = acc[ai][0][m][n][j] * rs, b = acc[ai][1][m][n][j] * rs;
                        const float r = __builtin_amdgcn_rcpf(__builtin_fmaf(__builtin_amdgcn_exp2f(a), -0.36067376022224085f, -0.36067376022224085f));
                        o[n * 4 + j] = (a * b) * r; }
                u32x2 w; w.x = pk4_fp8(o[0], o[1], o[2], o[3]); w.y = pk4_fp8(o[4], o[5], o[6], o[7]);
                *(u32x2*)(O + (size_t)row * ldc + col0) = w; PG8_ZERO(ai, m); }
    }
};

template <class Epi, bool MOE, bool FP8, bool ASPARSE = false>
__device__ __forceinline__ void gemm_phase(PG8_LAS unsigned char* lds, const Gemm g, const Sched& S, const Epi& E, const int tid) {
    const int wid = __builtin_amdgcn_readfirstlane(tid >> 6), lane = tid & 63, wr = wid >> 2, wc = wid & 3, fr = lane & 15, fq = lane >> 4;
    const int P = g.pitch, nt = P / (BK * 2);
    unsigned voffA[2], voffB[2];
#pragma unroll
    for (int i = 0; i < 2; ++i) { int R, C; stage_rc(tid * 16 + i * 8192, R, C); const int Rb = Epi::PERM ? ((R & ~31) + perm32(R & 31)) : R;
        voffA[i] = (unsigned)(R * P + C * 2); voffB[i] = (unsigned)(Rb * P + C * 2); }
    const size_t kstep = (size_t)(BK * 2);
    const size_t hstep = (size_t)HALF * P;
    const size_t tstep = 2 * hstep;
    const unsigned ldsw = (unsigned)wid * 1024u;
    const int aoff = lds_byte(wr * 64 + fr, fq * 8), boff = lds_byte(wc * 32 + fr, fq * 8);
#define PG8_SA(b, h) (((b) * 2 + (h)) * HTB)
#define PG8_SB(b, h) ((4 + (b) * 2 + (h)) * HTB)
#define PG8_STAGE(bufoff, gbase, voff) do { _Pragma("unroll") for (int _i = 0; _i < 2; ++_i) \
        __builtin_amdgcn_global_load_lds((const unsigned*)((const char*)(gbase) + (voff)[_i]), (PG8_LAS unsigned*)(lds + (bufoff) + ldsw + _i * 8192), 16, 0, 0); } while (0)
#define PG8_LDA(dst, b, h) do { _Pragma("unroll") for (int m = 0; m < 4; ++m) _Pragma("unroll") for (int k = 0; k < 2; ++k) dst[m][k] = *(const PG8_LAS bf16x8*)(lds + PG8_SA(b, h) + aoff + m * 2048 + k * 1024); } while (0)
#define PG8_LDB(dst, b, h) do { _Pragma("unroll") for (int n = 0; n < 2; ++n) _Pragma("unroll") for (int k = 0; k < 2; ++k) dst[n][k] = *(const PG8_LAS bf16x8*)(lds + PG8_SB(b, h) + boff + n * 2048 + k * 1024); } while (0)
#define PG8_CAT(x) __builtin_shufflevector(__builtin_bit_cast(i32x4, (x)[0]), __builtin_bit_cast(i32x4, (x)[1]), 0, 1, 2, 3, 4, 5, 6, 7)
#define PG8_MMA(ai, bj, At, Bt) do { __builtin_amdgcn_s_setprio(1); \
        if constexpr (FP8) { _Pragma("unroll") for (int m = 0; m < 4; ++m) _Pragma("unroll") for (int n = 0; n < 2; ++n) \
            asm volatile("v_mfma_scale_f32_16x16x128_f8f6f4 %0, %1, %2, %0, %3, %4 op_sel_hi:[0,0,0]" : "+v"(acc[ai][bj][m][n]) : "v"(PG8_CAT(Bt[n])), "v"(PG8_CAT(At[m])), "v"(sbv), "v"(sav)); } \
        else { _Pragma("unroll") for (int m = 0; m < 4; ++m) _Pragma("unroll") for (int n = 0; n < 2; ++n) _Pragma("unroll") for (int k = 0; k < 2; ++k) \
            acc[ai][bj][m][n] = __builtin_amdgcn_mfma_f32_16x16x32_bf16(Bt[n][k], At[m][k], acc[ai][bj][m][n], 0, 0, 0); } \
        __builtin_amdgcn_s_setprio(0); } while (0)
#define PG8_WAIT_V(n) asm volatile("s_waitcnt vmcnt(" #n ")" ::: "memory")
#define PG8_WAIT_L(n) asm volatile("s_waitcnt lgkmcnt(" #n ")" ::: "memory")
#define PG8_BAR __builtin_amdgcn_s_barrier()
#define PG8_SCHED __builtin_amdgcn_sched_barrier(0)
#define PG8_APTR(u) ((const char*)g.A + (ASPARSE ? (size_t)S.arow((u).pm) * (size_t)P : (size_t)(u).pm * tstep))
#define PG8_BPTR(u) ((const char*)g.Bt + (size_t)(u).pn * tstep + (MOE ? (size_t)S.expert((u).pm) * S.estride : (size_t)0))
    Unit cur, nxt; int ui = 0;
    if (!S.next(0, cur)) return;
    f32x4 acc[2][2][4][2];
#pragma unroll
    for (int a = 0; a < 2; ++a)
#pragma unroll
        for (int b = 0; b < 2; ++b)
#pragma unroll
            for (int m = 0; m < 4; ++m)
#pragma unroll
                for (int n = 0; n < 2; ++n) acc[a][b][m][n] = (f32x4){0.f, 0.f, 0.f, 0.f};
    bf16x8 At[4][2], B0[2][2], B1[2][2];
    const int sav = g.sa, sbv = g.sb;
    const char* cA = PG8_APTR(cur); const char* cB = PG8_BPTR(cur);
    PG8_STAGE(PG8_SB(0, 0), cB, voffB); PG8_STAGE(PG8_SB(0, 1), cB + hstep, voffB); PG8_STAGE(PG8_SA(0, 0), cA, voffA); PG8_STAGE(PG8_SA(0, 1), cA + hstep, voffA);
    if (wr == 1) PG8_BAR;
    PG8_WAIT_V(2); PG8_BAR;
    PG8_STAGE(PG8_SB(1, 0), cB + kstep, voffB); PG8_STAGE(PG8_SA(1, 0), cA + kstep, voffA); PG8_STAGE(PG8_SB(1, 1), cB + hstep + kstep, voffB);
    PG8_WAIT_V(6); PG8_BAR;
    for (;;) {
        const bool has_next = S.next(ui + 1, nxt);
        const char* nA = has_next ? PG8_APTR(nxt) : cA; const char* nB = has_next ? PG8_BPTR(nxt) : cB;
#pragma nounroll
        for (int t = 0; t < nt; t += 2) {
            const bool last = (t == nt - 2);
            const char* a1 = cA + (size_t)(t + 1) * kstep;
            const char* a2 = last ? nA : cA + (size_t)(t + 2) * kstep; const char* b2 = last ? nB : cB + (size_t)(t + 2) * kstep;
            const char* a3 = a2 + kstep; const char* b3 = b2 + kstep;
            PG8_LDB(B0, 0, 0); PG8_LDB(B1, 0, 1); PG8_SCHED; PG8_LDA(At, 0, 0); PG8_STAGE(PG8_SA(1, 1), a1 + hstep, voffA);
            PG8_WAIT_V(8); PG8_WAIT_L(0); PG8_BAR; PG8_MMA(0, 0, At, B0); PG8_MMA(0, 1, At, B1); PG8_BAR; PG8_SCHED;
            PG8_LDA(At, 0, 1); PG8_STAGE(PG8_SB(0, 0), b2, voffB); PG8_STAGE(PG8_SB(0, 1), b2 + hstep, voffB); PG8_STAGE(PG8_SA(0, 0), a2, voffA);
            PG8_WAIT_V(8); PG8_WAIT_L(0); PG8_BAR; PG8_MMA(1, 0, At, B0); PG8_MMA(1, 1, At, B1); PG8_BAR; PG8_SCHED;
            PG8_LDB(B0, 1, 0); PG8_LDB(B1, 1, 1); PG8_SCHED; PG8_LDA(At, 1, 0); PG8_STAGE(PG8_SA(0, 1), a2 + hstep, voffA);
            PG8_WAIT_V(8); PG8_WAIT_L(0); PG8_BAR; PG8_MMA(0, 0, At, B0); PG8_MMA(0, 1, At, B1); PG8_BAR; PG8_SCHED;
            PG8_LDA(At, 1, 1); PG8_STAGE(PG8_SB(1, 0), b3, voffB); PG8_STAGE(PG8_SB(1, 1), b3 + hstep, voffB); PG8_STAGE(PG8_SA(1, 0), a3, voffA);
            PG8_WAIT_V(8); PG8_WAIT_L(0); PG8_BAR; PG8_MMA(1, 0, At, B0); PG8_MMA(1, 1, At, B1); PG8_BAR; PG8_SCHED;
        }
        if constexpr (FP8) asm volatile("s_nop 15\n\ts_nop 15" ::: "memory");
        if (wr == 0) PG8_BAR;
        E(acc, cur, wr, wc, fr, fq);
        if (!has_next) break;
        cur = nxt; cA = nA; cB = nB; ++ui;
        if (wr == 1) PG8_BAR;
    }
    PG8_WAIT_V(0);
    PG8_BAR;
#undef PG8_SA
#undef PG8_SB
#undef PG8_STAGE
#undef PG8_LDA
#undef PG8_LDB
#undef PG8_MMA
#undef PG8_CAT
#undef PG8_WAIT_V
#undef PG8_WAIT_L
#undef PG8_BAR
#undef PG8_SCHED
#undef PG8_BPTR
#undef PG8_APTR
}
}

constexpr int NWAVES = 8;
constexpr int D = 1024, BATCH = 16, SEQ = 2048, T = BATCH * SEQ, DEPTH = 4;
constexpr int DCONV = 512, DLRU = 512, DIN = 2560, HD = 64, NHEAD = 8;
constexpr int DZ = 2048;
constexpr int FF = 3072, NE = 8, FFE = 3584;
constexpr int CAP = 2 * T + NE * 256;
constexpr float EPS = 1e-6f;
constexpr int NPHASE = 27;
constexpr float W1SCALE = 64.0f * -1.4426950408889634f;
constexpr int P0_EXPERTS = 0;

constexpr size_t MiB = 1u << 20;
constexpr size_t WS_CTL = 0, CTL_ZERO_BYTES = 7 * MiB / 2;
constexpr size_t WS_SUMSQ = 1 * MiB;
constexpr size_t WS_GWR = 4 * MiB;
constexpr size_t WS_TOKE = 5 * MiB, WS_TOKR = WS_TOKE + 256 * 1024, WS_TOKG = WS_TOKR + 256 * 1024, WS_TOKRS = WS_TOKG + 256 * 1024, WS_TOKPOS = WS_TOKRS + 128 * 1024;
constexpr size_t WS_WIN = 8 * MiB;
constexpr size_t WS_WOUT = WS_WIN + 20 * MiB;
constexpr size_t WS_W13 = WS_WOUT + 8 * MiB;
constexpr size_t WS_W2 = WS_W13 + 24 * MiB;
constexpr size_t WS_WE13 = WS_W2 + 12 * MiB;
constexpr size_t WS_WE2 = WS_WE13 + 112 * MiB;
constexpr size_t WS_HB = WS_WE2 + 56 * MiB;
constexpr size_t WS_XB = WS_HB + 64 * MiB;
constexpr size_t WS_BIG = WS_XB + 132 * MiB;
constexpr size_t WS_Z = WS_BIG, WS_Y = WS_BIG + 160 * MiB, WS_U = WS_BIG, WS_HID = WS_BIG + 231 * MiB;
constexpr size_t WS_XB8S = WS_XB;

constexpr size_t WS_END = WS_BIG + 462 * MiB;
static_assert(WS_XB8S + (size_t)NE * T * D <= WS_HID && WS_HID + (size_t)CAP * FFE <= WS_END, "MoE buffers");
static_assert(WS_WE13 == 72 * MiB && WS_HB == 240 * MiB && WS_BIG == 436 * MiB && WS_END == 898 * MiB, "ws map");
static_assert((size_t)CAP * 1024 * 2 == 132 * MiB && (size_t)CAP * FFE * 2 == 462 * MiB, "cap");
constexpr int CW_TMO = 0;
constexpr int CW_BAR = 4096;
constexpr int CW_GCNT = 8192;

constexpr int RING_OFF = 0, RING_BYTES = 131072;
constexpr int LDS_BYTES = 147456;
constexpr int LDSCTL_OFF = LDS_BYTES - 1024, MISC_OFF = LDSCTL_OFF + 320;
constexpr int MX_STRIDE = 144;
constexpr int MX_XRW = 35 * MX_STRIDE;
constexpr int MX_XR = 0, MX_GR = 8 * MX_XRW, MX_CB = MX_GR + 36864, MX_TOT = MX_CB + 36864, MX_CW = MX_TOT + 2 * 4096, MX_WT = MX_CW + 1280, MX_END = MX_WT + 128 * MX_STRIDE;
static_assert(MX_END <= LDSCTL_OFF && (MX_WT % 16) == 0 && (MX_GR % 16) == 0, "mixer LDS");

#define GAS __attribute__((address_space(1)))
#define LAS __attribute__((address_space(3)))
typedef unsigned short bf16;
typedef unsigned v4u __attribute__((ext_vector_type(4)));
typedef unsigned v2u __attribute__((ext_vector_type(2)));
typedef float f32x4 __attribute__((ext_vector_type(4)));
typedef short bf16x8 __attribute__((ext_vector_type(8)));
typedef GAS unsigned gu32;
typedef float f32x2 __attribute__((ext_vector_type(2)));
#define RLX_AGENT __ATOMIC_RELAXED, __HIP_MEMORY_SCOPE_AGENT
#define LDS_WAIT() asm volatile("s_waitcnt lgkmcnt(0)" ::: "memory")
#define LDS_SYNC() asm volatile("s_waitcnt lgkmcnt(0)\n\ts_barrier" ::: "memory")
__device__ __forceinline__ unsigned f2bf(float f) { unsigned u = __builtin_bit_cast(unsigned, f); return (u + 0x7fffu + ((u >> 16) & 1u)) >> 16; }
__device__ __forceinline__ unsigned pk2(float lo, float hi) { return pg8::cvt_pk_bf16(lo, hi); }
__device__ __forceinline__ float bflo(unsigned w) { return __builtin_bit_cast(float, w << 16); }
__device__ __forceinline__ float bfhi(unsigned w) { return __builtin_bit_cast(float, w & 0xffff0000u); }
__device__ __forceinline__ float row_sum16(float v) {
    v += __builtin_bit_cast(float, __builtin_amdgcn_update_dpp(0, __builtin_bit_cast(int, v), 0xB1, 0xF, 0xF, false));
    v += __builtin_bit_cast(float, __builtin_amdgcn_update_dpp(0, __builtin_bit_cast(int, v), 0x4E, 0xF, 0xF, false));
    v += __builtin_bit_cast(float, __builtin_amdgcn_update_dpp(0, __builtin_bit_cast(int, v), 0x141, 0xF, 0xF, false));
    v += __builtin_bit_cast(float, __builtin_amdgcn_update_dpp(0, __builtin_bit_cast(int, v), 0x140, 0xF, 0xF, false));
    return v;
}
__device__ __forceinline__ float wave_sum(float v) {
    v = row_sum16(v); v += __shfl_xor(v, 16); v += __shfl_xor(v, 32);
    return v;
}

#define XB_TMO      128
#define XB_XCNT(j)  (256  + 64 * (j))
#define XB_XSUB(j)  (1280 + 64 * (j))
#define XB_XGEN(j)  (2304 + 64 * (j))
#define XB_TOP      3328
#define XB_TOPGEN   3392
#define XCD_BAR_WORDS 3456
#define XB_SPIN_CAP (1u << 18)

__device__ __forceinline__ unsigned xb_ld(unsigned* p)              { return __hip_atomic_load(p, __ATOMIC_RELAXED, __HIP_MEMORY_SCOPE_AGENT); }
__device__ __forceinline__ unsigned xb_add(unsigned* p, unsigned v) { return __hip_atomic_fetch_add(p, v, __ATOMIC_RELAXED, __HIP_MEMORY_SCOPE_AGENT); }
__device__ __forceinline__ unsigned xb_xcc_id() { return (unsigned)__builtin_amdgcn_s_getreg((3 << 11) | 20) & 0xFu; }
#define XB_SPIN(cond, bar) do { unsigned _sp = 0; while (cond) { __builtin_amdgcn_s_sleep(1); \
    if ((++_sp & 255u) == 0u) { if (xb_ld(&(bar)[XB_TMO])) break; if (_sp > XB_SPIN_CAP) { atomicAdd(&(bar)[XB_TMO], 1u); break; } } } } while (0)

struct XcdBarrier {
    unsigned* bar; unsigned x;
    volatile LAS unsigned* st;
};

__device__ __forceinline__ XcdBarrier xcd_barrier_post(unsigned* bar, volatile LAS unsigned* st) {
    XcdBarrier b; b.bar = bar; b.x = xb_xcc_id(); b.st = st;
    if (threadIdx.x == 0) (void)xb_add(&bar[XB_XCNT(b.x)], 1u);
    return b;
}
__device__ __forceinline__ void xcd_barrier_complete(unsigned* bar, unsigned x, unsigned& nloc, unsigned& nx) {
    const unsigned G = gridDim.x * gridDim.y * gridDim.z;
    unsigned sum, cnt, mine, sp = 0u;
    for (;;) {
        sum = 0u; cnt = 0u; mine = 0u;
#pragma unroll
        for (unsigned j = 0; j < 16; ++j) { const unsigned c = xb_ld(&bar[XB_XCNT(j)]); sum += c; cnt += (c > 0u) ? 1u : 0u; mine = (j == x) ? c : mine; }
        if (sum == G) break;
        __builtin_amdgcn_s_sleep(1);
        if ((++sp & 255u) == 0u) { if (xb_ld(&bar[XB_TMO])) break; if (sp > XB_SPIN_CAP) { atomicAdd(&bar[XB_TMO], 1u); break; } }
    }
    nloc = mine > 0u ? mine : 1u; nx = cnt > 0u ? cnt : 1u;
}

__device__ __forceinline__ void xcd_barrier(const XcdBarrier& b) {
    asm volatile("s_waitcnt vmcnt(0)" ::: "memory");
    __syncthreads();
    if (threadIdx.x == 0) {
        unsigned* bar = b.bar;
        __builtin_amdgcn_s_waitcnt(0);
        unsigned nloc = b.st[0], nx = b.st[1];
        if (nloc == 0u) { xcd_barrier_complete(bar, b.x, nloc, nx); b.st[0] = nloc; b.st[1] = nx; }
        const unsigned old = xb_add(&bar[XB_XSUB(b.x)], 1u);
        const unsigned gen = old / nloc;
        if (old + 1u == (gen + 1u) * nloc) {
            __builtin_amdgcn_fence(__ATOMIC_RELEASE, "agent");
            asm volatile("s_waitcnt vmcnt(0)" ::: "memory");
            const unsigned og = xb_add(&bar[XB_TOP], 1u);
            const unsigned tg = og / nx;
            if (og + 1u == (tg + 1u) * nx) xb_add(&bar[XB_TOPGEN], 1u);
            else XB_SPIN(xb_ld(&bar[XB_TOPGEN]) == tg, bar);
            __builtin_amdgcn_fence(__ATOMIC_ACQUIRE, "agent");
            xb_add(&bar[XB_XGEN(b.x)], 1u);
            asm volatile("s_waitcnt vmcnt(0)" ::: "memory");
        } else {
            XB_SPIN(xb_ld(&bar[XB_XGEN(b.x)]) == gen, bar);
            __builtin_amdgcn_fence(__ATOMIC_ACQUIRE, "agent");
            asm volatile("s_waitcnt vmcnt(0)" ::: "memory");
        }
    }
    __syncthreads();
}

struct Frame {
    LAS unsigned char* lds;
    volatile LAS unsigned* MISC;
    unsigned* ctl;
    int tid, lane, wave;
    int vcu, G, bx;
    unsigned char* ws;
    const float* const* in;
    float* out;
};
enum { I_X = 0, I_NMG, I_WIN, I_CAW, I_CAB, I_CBW, I_CBB, I_LWR, I_LBR, I_LWI, I_LBI, I_LAM, I_MOG, I_WOUT, I_NFG, I_FW1, I_FW3, I_FW2, I_RW, I_EW1, I_EW3, I_EW2, I_FG };

__device__ __forceinline__ void transpose_load(const float* W, int N, int item, int lane, f32x4 (&v)[16]) {
    const int nblk = N / 64, kb = item / nblk, nb = item % nblk, kq = lane >> 4, nq = lane & 15;
    const f32x4* src = (const f32x4*)(W + (size_t)(64 * kb + 16 * kq) * N + 64 * nb + 4 * nq);
#pragma unroll
    for (int i = 0; i < 16; ++i) v[i] = src[(size_t)i * (N / 4)];
}
template <bool FP8>
__device__ __forceinline__ void transpose_finish(f32x4 (&v)[16], int K, int N, void* WTv, const float* gain, float mul, int mode, int item, int lane) {
    const int nblk = N / 64, kb = item / nblk, nb = item % nblk, kq = lane >> 4, nq = lane & 15;
    const int kbase = 64 * kb + 16 * kq, nbase = 64 * nb + 4 * nq;
    if (gain) { const f32x4* gp = (const f32x4*)(gain + kbase);
#pragma unroll
        for (int q4 = 0; q4 < 4; ++q4) { const f32x4 g4 = gp[q4] * mul;
#pragma unroll
            for (int t = 0; t < 4; ++t) v[4 * q4 + t] = v[4 * q4 + t] * g4[t]; } }
    else {
#pragma unroll
        for (int i = 0; i < 16; ++i) v[i] = v[i] * mul; }
#pragma unroll
    for (int q = 0; q < 4; ++q) { const int nn = nbase + q;
        const int dr = (mode == 0) ? nn : (mode == 3) ? (nn < 512 ? 256 * (nn >> 7) + (nn & 127) : nn < 1024 ? nn + 512 : nn < 1536 ? 256 * ((nn - 1024) >> 7) + 128 + (nn & 127) : nn)
                                   : (256 * (nn >> 7) + (nn & 127) + (mode == 2 ? 128 : 0));
        if constexpr (FP8) { v4u o; o.x = pg8::pk4_fp8(v[0][q], v[1][q], v[2][q], v[3][q]); o.y = pg8::pk4_fp8(v[4][q], v[5][q], v[6][q], v[7][q]);
            o.z = pg8::pk4_fp8(v[8][q], v[9][q], v[10][q], v[11][q]); o.w = pg8::pk4_fp8(v[12][q], v[13][q], v[14][q], v[15][q]);
            *(v4u*)((unsigned char*)WTv + (size_t)dr * K + kbase) = o; }
        else { v4u o0, o1; o0.x = pk2(v[0][q], v[1][q]); o0.y = pk2(v[2][q], v[3][q]); o0.z = pk2(v[4][q], v[5][q]); o0.w = pk2(v[6][q], v[7][q]);
            o1.x = pk2(v[8][q], v[9][q]); o1.y = pk2(v[10][q], v[11][q]); o1.z = pk2(v[12][q], v[13][q]); o1.w = pk2(v[14][q], v[15][q]);
            v4u* dst = (v4u*)((bf16*)WTv + (size_t)dr * K + kbase); dst[0] = o0; dst[1] = o1; } }
}
template <bool FP8>
__device__ __forceinline__ void transpose_item(const float* W, int K, int N, void* WTv, const float* gain, float mul, int mode, int item, int lane) {
    f32x4 v[16]; transpose_load(W, N, item, lane, v); transpose_finish<FP8>(v, K, N, WTv, gain, mul, mode, item, lane);
}
template <bool FP8>
__device__ __forceinline__ void convert_matrix(Frame& F, const float* W, int K, int N, void* WT, const float* gain, float mul, int mode, int& rot, int gw, int NGW) {
    const int nitems = (K / 64) * (N / 64);
    int first = gw - rot; if (first < 0) first += NGW;
    for (int it = first; it < nitems; it += NGW) transpose_item<FP8>(W, K, N, WT, gain, mul, mode, it, F.lane);
    rot = (rot + nitems) % NGW;
}
__device__ __forceinline__ void convert_experts(Frame& F, int j, int e_lo, int e_hi, int& rot, int gw, int NGW) {
    const float* g = F.in[I_NFG] + (size_t)(2 * j + 1) * D;
    for (int e = e_lo; e < e_hi; ++e) {
        const size_t eo = ((size_t)j * NE + e) * (size_t)D * FFE;
        unsigned char* w13 = F.ws + WS_WE13 + ((size_t)j * NE + e) * (size_t)(2 * FFE) * D;
        convert_matrix<true>(F, F.in[I_EW1] + eo, D, FFE, w13, g, W1SCALE, 1, rot, gw, NGW);
        convert_matrix<true>(F, F.in[I_EW3] + eo, D, FFE, w13, g, 64.0f, 2, rot, gw, NGW);
        convert_matrix<true>(F, F.in[I_EW2] + eo, FFE, D, F.ws + WS_WE2 + ((size_t)j * NE + e) * (size_t)D * FFE, nullptr, 128.0f, 0, rot, gw, NGW);
    }
}
struct XItem { const float* W; unsigned char* WT; const float* gain; float mul; int K, N, mode, item; };
__device__ __forceinline__ XItem xitem(Frame& F, int j, int e_lo, int g) {
    constexpr int IPM = (D / 64) * (FFE / 64);
    const int e = e_lo + g / (3 * IPM), r = g % (3 * IPM), mat = r / IPM;
    const size_t eo = ((size_t)j * NE + e) * (size_t)D * FFE;
    XItem x; x.item = r % IPM;
    if (mat < 2) { x.W = F.in[mat == 0 ? I_EW1 : I_EW3] + eo; x.WT = F.ws + WS_WE13 + ((size_t)j * NE + e) * (size_t)(2 * FFE) * D; x.gain = F.in[I_NFG] + (size_t)(2 * j + 1) * D; x.mul = (mat == 0) ? W1SCALE : 64.0f; x.K = D; x.N = FFE; x.mode = 1 + mat; }
    else { x.W = F.in[I_EW2] + eo; x.WT = F.ws + WS_WE2 + ((size_t)j * NE + e) * (size_t)D * FFE; x.gain = nullptr; x.mul = 128.0f; x.K = FFE; x.N = D; x.mode = 0; }
    return x;
}
__device__ __forceinline__ void convert_experts_pipe(Frame& F, int j, int e_lo, int e_hi, int gw, int NGW) {
    constexpr int IPM = (D / 64) * (FFE / 64);
    const int total = (e_hi - e_lo) * 3 * IPM;
    for (int g = gw; g < total; g += NGW) { f32x4 va[16]; const XItem xa = xitem(F, j, e_lo, g); transpose_load(xa.W, xa.N, xa.item, F.lane, va);
        transpose_finish<true>(va, xa.K, xa.N, xa.WT, xa.gain, xa.mul, xa.mode, xa.item, F.lane); }
}
__device__ __forceinline__ void p0_prologue(Frame& F) {
    int rot = 0; const int gw0 = F.vcu * NWAVES + F.wave, NGW0 = F.G * NWAVES;
    for (int l = 0; l < DEPTH; ++l) {
        convert_matrix<false>(F, F.in[I_WIN] + (size_t)l * D * DIN, D, DIN, (bf16*)(F.ws + WS_WIN) + (size_t)l * DIN * D, F.in[I_NMG] + l * D, 1.0f, 3, rot, gw0, NGW0);
        convert_matrix<false>(F, F.in[I_WOUT] + (size_t)l * D * D, D, D, (bf16*)(F.ws + WS_WOUT) + (size_t)l * D * D, F.in[I_MOG] + l * D, 1.0f, 0, rot, gw0, NGW0);
    }
    for (int dj = 0; dj < 2; ++dj) {
        unsigned char* w13 = F.ws + WS_W13 + (size_t)dj * (2 * FF) * D;
        convert_matrix<true>(F, F.in[I_FW1] + (size_t)dj * D * FF, D, FF, w13, F.in[I_NFG] + 2 * dj * D, W1SCALE, 1, rot, gw0, NGW0);
        convert_matrix<true>(F, F.in[I_FW3] + (size_t)dj * D * FF, D, FF, w13, F.in[I_NFG] + 2 * dj * D, 64.0f, 2, rot, gw0, NGW0);
        convert_matrix<true>(F, F.in[I_FW2] + (size_t)dj * FF * D, FF, D, F.ws + WS_W2 + (size_t)dj * D * FF, nullptr, 128.0f, 0, rot, gw0, NGW0);
    }
    convert_experts(F, 0, 0, P0_EXPERTS, rot, gw0, NGW0); convert_experts(F, 1, 0, P0_EXPERTS, rot, gw0, NGW0);
    { float* gwr = (float*)(F.ws + WS_GWR);
      for (int i = F.bx * (NWAVES * 64) + F.tid; i < 2 * D * NE; i += F.G * NWAVES * 64) { const int j = i / (D * NE), d = (i / NE) % D;
          gwr[i] = F.in[I_RW][i] * F.in[I_NFG][(2 * j + 1) * D + d]; } }
    { const int gw = F.vcu * NWAVES + F.wave, NGW = F.G * NWAVES; pg8::u64* sumsq = (pg8::u64*)(F.ws + WS_SUMSQ); bf16* hb = (bf16*)(F.ws + WS_HB);
      for (int mb = gw; mb < T; mb += 4 * NGW) {
          f32x4 v[4][4];
#pragma unroll
          for (int u = 0; u < 4; ++u) { const int m = (mb + u * NGW < T) ? mb + u * NGW : mb; const f32x4* xr = (const f32x4*)(F.in[I_X] + (size_t)m * D) + F.lane;
#pragma unroll
              for (int i = 0; i < 4; ++i) v[u][i] = xr[64 * i]; }
#pragma unroll
          for (int u = 0; u < 4; ++u) { const int m = mb + u * NGW; if (m < T) { v2u* o8 = (v2u*)(hb + (size_t)m * D) + F.lane; float s = 0.f;
#pragma unroll
              for (int i = 0; i < 4; ++i) { const f32x4 x = v[u][i]; s += (x.x * x.x + x.y * x.y) + (x.z * x.z + x.w * x.w); v2u w; w.x = pk2(x.x, x.y); w.y = pk2(x.z, x.w); o8[64 * i] = w; }
              s = wave_sum(s); if (F.lane == 0) sumsq[m] = pg8::ss_to_fx(s); } } } }
}

__device__ __forceinline__ void mix_conv_a(Frame& F, int l, int idx, int nwg) {
    const bf16* z = (const bf16*)(F.ws + WS_Z); bf16* y = (bf16*)(F.ws + WS_Y);
    const int c0 = 8 * F.lane;
    float w0[8], w1[8], w2[8], bs[8];
    { const float* cw = F.in[I_CAW] + (size_t)l * 3 * DCONV; const float* cb = F.in[I_CAB] + (size_t)l * DCONV;
#pragma unroll
      for (int q = 0; q < 8; ++q) { w0[q] = cw[c0 + q]; w1[q] = cw[DCONV + c0 + q]; w2[q] = cw[2 * DCONV + c0 + q]; bs[q] = cb[c0 + q]; } }
    for (int it = idx * NWAVES + F.wave; it < T / 32; it += nwg * NWAVES) {
        const int t0 = it * 32;
        float v1[8], v2[8];
#pragma unroll
        for (int q = 0; q < 8; ++q) { v1[q] = 0.f; v2[q] = 0.f; }
        if ((t0 % SEQ) != 0) {
            const v4u q2 = *(const v4u*)(z + (size_t)(t0 - 2) * DZ + c0), q1 = *(const v4u*)(z + (size_t)(t0 - 1) * DZ + c0);
#pragma unroll
            for (int q = 0; q < 4; ++q) { v2[2 * q] = bflo(q2[q]); v2[2 * q + 1] = bfhi(q2[q]); v1[2 * q] = bflo(q1[q]); v1[2 * q + 1] = bfhi(q1[q]); }
        }
#pragma unroll 8
        for (int tt = 0; tt < 32; ++tt) {
            const size_t t = (size_t)(t0 + tt);
            const v4u vv = *(const v4u*)(z + t * DZ + c0), gb = *(const v4u*)(z + t * DZ + DCONV + c0);
            float v[8], ya[8]; float ss = 0.f;
#pragma unroll
            for (int q = 0; q < 4; ++q) { v[2 * q] = bflo(vv[q]); v[2 * q + 1] = bfhi(vv[q]); }
#pragma unroll
            for (int q = 0; q < 8; ++q) { const float ca = bs[q] + w0[q] * v2[q] + w1[q] * v1[q] + w2[q] * v[q];
                const float g = (q & 1) ? bfhi(gb[q >> 1]) : bflo(gb[q >> 1]); ya[q] = g * ca; ss += ya[q] * ya[q]; v2[q] = v1[q]; v1[q] = v[q]; }
            ss += __builtin_bit_cast(float, __builtin_amdgcn_update_dpp(0, __builtin_bit_cast(int, ss), 0xB1, 0xF, 0xF, false));
            ss += __builtin_bit_cast(float, __builtin_amdgcn_update_dpp(0, __builtin_bit_cast(int, ss), 0x4E, 0xF, 0xF, false));
            ss += __builtin_bit_cast(float, __builtin_amdgcn_update_dpp(0, __builtin_bit_cast(int, ss), 0x141, 0xF, 0xF, false));
            const float sc = __builtin_amdgcn_rsqf(ss * (1.0f / 64.0f) + EPS);
            v4u o; o.x = pk2(ya[0] * sc, ya[1] * sc); o.y = pk2(ya[2] * sc, ya[3] * sc); o.z = pk2(ya[4] * sc, ya[5] * sc); o.w = pk2(ya[6] * sc, ya[7] * sc);
            *(v4u*)(y + t * D + c0) = o;
        }
    }
}

__device__ __forceinline__ float lane_even(float v) { const unsigned u = __builtin_bit_cast(unsigned, v); auto r = __builtin_amdgcn_permlane16_swap(u, u, false, false); const unsigned t = r[0]; return __builtin_bit_cast(float, t); }
__device__ __forceinline__ float lane_row1(float v) { const unsigned u = __builtin_bit_cast(unsigned, v); auto r = __builtin_amdgcn_permlane32_swap(u, u, false, false); const unsigned z = r[0]; auto q = __builtin_amdgcn_permlane16_swap(z, z, false, false); const unsigned t = q[1]; return __builtin_bit_cast(float, t); }
__device__ __forceinline__ float lane_row3(float v) { const unsigned u = __builtin_bit_cast(unsigned, v); auto r = __builtin_amdgcn_permlane32_swap(u, u, false, false); const unsigned z = r[1]; auto q = __builtin_amdgcn_permlane16_swap(z, z, false, false); const unsigned t = q[1]; return __builtin_bit_cast(float, t); }
__device__ __forceinline__ void mix_lru(Frame& F, int l, int idx, int nwg) {
    const bf16* z = (const bf16*)(F.ws + WS_Z); bf16* y = (bf16*)(F.ws + WS_Y);
    LAS unsigned char* lds = F.lds;
    const int lane = F.lane, w = F.wave, fr = lane & 15, fq = lane >> 4, tid = F.tid;
    bf16x8 Iden[2];
#pragma unroll
    for (int par = 0; par < 2; ++par) { v4u q = (v4u){0u, 0u, 0u, 0u};
        if (fq == 2 * par + (fr >> 3)) { const int j = fr & 7; const unsigned one = 0x3F80u << (16 * (j & 1));
            q.x = (j >> 1) == 0 ? one : 0u; q.y = (j >> 1) == 1 ? one : 0u; q.z = (j >> 1) == 2 ? one : 0u; q.w = (j >> 1) == 3 ? one : 0u; }
        Iden[par] = __builtin_bit_cast(bf16x8, q); }
    const int rq = lane >> 3, pcg = lane & 7;
    LAS unsigned char* xrw = lds + MX_XR + w * MX_XRW;
    for (int u = idx; u < BATCH * NHEAD; u += nwg) {
        const int b = u >> 3, hh = u & 7;
        const bf16* zx = z + (size_t)(b * SEQ + 32 * w) * DZ + 2 * DCONV + hh * HD + 8 * pcg;
        LDS_SYNC();
        if (tid < 320) { const int k = tid >> 6, c = tid & 63;
            ((LAS float*)(lds + MX_CW))[tid] = (k < 4) ? F.in[I_CBW][((size_t)l * 4 + k) * DLRU + hh * HD + c] : F.in[I_CBB][(size_t)l * DLRU + hh * HD + c]; }
        { const float* wr_ = F.in[I_LWR] + ((size_t)l * NHEAD + hh) * HD * HD; const float* wi_ = F.in[I_LWI] + ((size_t)l * NHEAD + hh) * HD * HD;
          for (int p = tid; p < 128 * 8; p += NWAVES * 64) { const int col = p >> 3, kc = p & 7, e = col & 63; const float* src = (col < 64 ? wr_ : wi_) + (size_t)(8 * kc) * HD + e;
              const float nl2 = -1.4426950408889634f;
              v4u o; o.x = pk2(src[0] * nl2, src[HD] * nl2); o.y = pk2(src[2 * HD] * nl2, src[3 * HD] * nl2); o.z = pk2(src[4 * HD] * nl2, src[5 * HD] * nl2); o.w = pk2(src[6 * HD] * nl2, src[7 * HD] * nl2);
              *(LAS v4u*)(lds + MX_WT + col * MX_STRIDE + kc * 16) = o; } }
        LDS_SYNC();
        float cbr[4], cbi[4], ck2[4], Hs[4];
#pragma unroll
        for (int n = 0; n < 4; ++n) { const int c = l * DLRU + hh * HD + 16 * n + fr;
            cbr[n] = F.in[I_LBR][c] * -1.4426950408889634f; cbi[n] = F.in[I_LBI][c] * -1.4426950408889634f;
            const float lam = F.in[I_LAM][c]; const float sp = (lam > 20.f) ? __expf(-lam) : log1pf(expf(-lam));
            ck2[n] = -8.0f * sp * 1.4426950408889634f; Hs[n] = 0.f; }
        v4u px[4], pg[4], ph;
#pragma unroll
        for (int i = 0; i < 4; ++i) { const bf16* src = zx + (size_t)(rq + 8 * i) * DZ; px[i] = *(const v4u*)src; pg[i] = *(const v4u*)(src + DLRU); }
        { unsigned z0 = 0u; asm volatile("" : "+v"(z0)); ph = (v4u){z0, z0, z0, z0}; if (lane < 24 && w > 0) ph = *(const v4u*)(zx + ((long)rq - 3) * DZ); }
        for (int ck = 0; ck < SEQ / 256; ++ck) {
            const int tok0 = b * SEQ + ck * 256;
#pragma unroll
            for (int i = 0; i < 4; ++i) { *(LAS v4u*)(xrw + (3 + rq + 8 * i) * MX_STRIDE + pcg * 16) = px[i]; *(LAS v4u*)(lds + MX_GR + (32 * w + rq + 8 * i) * MX_STRIDE + pcg * 16) = pg[i]; }
            if (lane < 24) *(LAS v4u*)(xrw + rq * MX_STRIDE + pcg * 16) = ph;
            if (ck + 1 < SEQ / 256) {
#pragma unroll
                for (int i = 0; i < 4; ++i) { const bf16* src = zx + (size_t)((ck + 1) * 256 + rq + 8 * i) * DZ; px[i] = *(const v4u*)src; pg[i] = *(const v4u*)(src + DLRU); }
                if (lane < 24) ph = *(const v4u*)(zx + ((long)(ck + 1) * 256 + rq - 3) * DZ); }
            { const int cg = lane & 7;
              f32x4 cw[5][2];
#pragma unroll
              for (int k = 0; k < 5; ++k) { const LAS f32x4* wp = (const LAS f32x4*)(lds + MX_CW + k * 64 * 4 + cg * 32); cw[k][0] = wp[0]; cw[k][1] = wp[1]; }
#pragma unroll
              for (int i = 0; i < 4; ++i) { const int tl = (lane >> 3) + 8 * i, r = 32 * w + tl;
                f32x4 a0 = cw[4][0], a1 = cw[4][1];
#pragma unroll
                for (int k = 0; k < 4; ++k) { const v4u x = *(const LAS v4u*)(xrw + (tl + k) * MX_STRIDE + cg * 16);
                    a0 += cw[k][0] * (f32x4){bflo(x[0]), bfhi(x[0]), bflo(x[1]), bfhi(x[1])}; a1 += cw[k][1] * (f32x4){bflo(x[2]), bfhi(x[2]), bflo(x[3]), bfhi(x[3])}; }
                v4u o; o.x = pk2(a0[0], a0[1]); o.y = pk2(a0[2], a0[3]); o.z = pk2(a1[0], a1[1]); o.w = pk2(a1[2], a1[3]);
                *(LAS v4u*)(lds + MX_CB + r * MX_STRIDE + cg * 16) = o; } }
            LDS_WAIT();
            const int arow = 32 * w + 8 * (fr >> 2) + (fr & 3);
            f32x4 ar[2][4], ai[2][4];
#pragma unroll
            for (int m = 0; m < 2; ++m) {
                bf16x8 Af[2];
#pragma unroll
                for (int ks = 0; ks < 2; ++ks) Af[ks] = *(const LAS bf16x8*)(lds + MX_CB + (arow + 4 * m) * MX_STRIDE + ks * 64 + fq * 16);
#pragma unroll
                for (int n = 0; n < 4; ++n) { f32x4 cr = (f32x4){cbr[n], cbr[n], cbr[n], cbr[n]}, ci = (f32x4){cbi[n], cbi[n], cbi[n], cbi[n]};
#pragma unroll
                    for (int ks = 0; ks < 2; ++ks) { const bf16x8 br = *(const LAS bf16x8*)(lds + MX_WT + (16 * n + fr) * MX_STRIDE + ks * 64 + fq * 16), bi = *(const LAS bf16x8*)(lds + MX_WT + (64 + 16 * n + fr) * MX_STRIDE + ks * 64 + fq * 16);
                        cr = __builtin_amdgcn_mfma_f32_16x16x32_bf16(Af[ks], br, cr, 0, 0, 0); ci = __builtin_amdgcn_mfma_f32_16x16x32_bf16(Af[ks], bi, ci, 0, 0, 0); }
                    const f32x4 cbt = __builtin_amdgcn_mfma_f32_16x16x32_bf16(Af[n >> 1], Iden[n & 1], (f32x4){0.f, 0.f, 0.f, 0.f}, 0, 0, 0);
                    float A[4], B[4];
#pragma unroll
                    for (int j = 0; j < 4; ++j) {
                        const float rg = __builtin_amdgcn_rcpf(1.0f + __builtin_amdgcn_exp2f(cr[j]));
                        const float ig = __builtin_amdgcn_rcpf(1.0f + __builtin_amdgcn_exp2f(ci[j]));
                        const float a = __builtin_amdgcn_exp2f(rg * ck2[n]);
                        const float mult = __builtin_amdgcn_sqrtf(1.0f - a * a);
                        const float uu = mult * ig * cbt[j];
                        if (j == 0) { if (m == 0) { A[0] = a; B[0] = uu; } else { A[0] = a * ar[0][n][3]; B[0] = a * ai[0][n][3] + uu; } }
                        else { A[j] = a * A[j - 1]; B[j] = a * B[j - 1] + uu; }
                    }
                    ar[m][n] = (f32x4){A[0], A[1], A[2], A[3]}; ai[m][n] = (f32x4){B[0], B[1], B[2], B[3]};
                } }
            float TA[4], TB[4], XA[4], XB_[4];
#pragma unroll
            for (int n = 0; n < 4; ++n) {
                float Ag_ = ar[1][n][3], Bg_ = ai[1][n][3];
                { const float Ap = lane_even(Ag_), Bp = lane_even(Bg_); if (fq & 1) { Bg_ = Ag_ * Bp + Bg_; Ag_ = Ap * Ag_; } }
                const float PA = lane_row1(Ag_), PB = lane_row1(Bg_);
                if (fq >= 2) { Bg_ = Ag_ * PB + Bg_; Ag_ = PA * Ag_; }
                float Ax = lane_even(Ag_), Bx = lane_even(Bg_);
                if (fq == 2) { Ax = PA; Bx = PB; }
                if (fq == 0) { Ax = 1.0f; Bx = 0.0f; }
                TA[n] = lane_row3(Ag_); TB[n] = lane_row3(Bg_);
                XA[n] = Ax; XB_[n] = Bx;
            }
            if (fq == 0) {
#pragma unroll
                for (int n = 0; n < 4; ++n)
                    *(LAS f32x2*)(lds + MX_TOT + (ck & 1) * 4096 + ((w * 64) + 16 * n + fr) * 8) = (f32x2){TA[n], TB[n]}; }
            LDS_SYNC();
            float EL[4];
#pragma unroll
            for (int n = 0; n < 4; ++n) { float st = Hs[n], mine = 0.f;
#pragma unroll
                for (int v = 0; v < 8; ++v) { if (v == w) mine = st; const f32x2 ab = *(const LAS f32x2*)(lds + MX_TOT + (ck & 1) * 4096 + ((v * 64) + 16 * n + fr) * 8); st = ab.x * st + ab.y; }
                Hs[n] = st; EL[n] = XA[n] * mine + XB_[n]; }
#pragma unroll
            for (int m = 0; m < 2; ++m) {
                f32x4 gt[4];
                { bf16x8 Ag[2];
#pragma unroll
                  for (int ks = 0; ks < 2; ++ks) Ag[ks] = *(const LAS bf16x8*)(lds + MX_GR + (arow + 4 * m) * MX_STRIDE + ks * 64 + fq * 16);
#pragma unroll
                  for (int n = 0; n < 4; ++n) gt[n] = __builtin_amdgcn_mfma_f32_16x16x32_bf16(Ag[n >> 1], Iden[n & 1], (f32x4){0.f, 0.f, 0.f, 0.f}, 0, 0, 0); }
#pragma unroll
                for (int j = 0; j < 4; ++j) {
                    const int tl = 8 * fq + 4 * m + j; float yv[4]; float ss = 0.f;
#pragma unroll
                    for (int n = 0; n < 4; ++n) {
                        const float hv = ar[m][n][j] * EL[n] + ai[m][n][j];
                        yv[n] = hv * gt[n][j]; ss += yv[n] * yv[n]; }
                    ss = row_sum16(ss);
                    const float sc = __builtin_amdgcn_rsqf(ss * (1.0f / 64.0f) + EPS);
#pragma unroll
                    for (int n = 0; n < 4; ++n) { const float yo = yv[n] * sc; *(LAS unsigned short*)(lds + MX_CB + (32 * w + tl) * MX_STRIDE + (16 * n + fr) * 2) = (unsigned short)pk2(yo, yo); }
                } }
            LDS_WAIT();
#pragma unroll
            for (int i = 0; i < 4; ++i) { const int item = lane + 64 * i, tl = item >> 3, cg = item & 7, r = 32 * w + tl;
                *(v4u*)(y + (size_t)(tok0 + r) * D + DCONV + hh * HD + 8 * cg) = *(const LAS v4u*)(lds + MX_CB + r * MX_STRIDE + cg * 16); }
        }
    }
}

#define RT_STEP(v_, i_, ctrl_) do { const float ov_ = __builtin_bit_cast(float, __builtin_amdgcn_update_dpp(0, __builtin_bit_cast(int, v_), ctrl_, 0xF, 0xF, false)); \
        const int oi_ = __builtin_amdgcn_update_dpp(0, i_, ctrl_, 0xF, 0xF, false); if (ov_ > v_ || (ov_ == v_ && oi_ < i_)) { v_ = ov_; i_ = oi_; } } while (0)
__device__ __forceinline__ void rt_phase(Frame& F, int j) {
    const bf16* h = (const bf16*)(F.ws + WS_HB); const float* gwr = (const float*)(F.ws + WS_GWR) + (size_t)j * D * NE;
    int* tokE = (int*)(F.ws + WS_TOKE); int* tokR = (int*)(F.ws + WS_TOKR); float* tokG = (float*)(F.ws + WS_TOKG); unsigned char* xb = F.ws + WS_XB8S;
    unsigned* gcnt = F.ctl + CW_GCNT + j * 8 * 64;
    LAS int* lcnt = (LAS int*)(F.lds + 0); LAS int* lbase = (LAS int*)(F.lds + 64);
    LAS int* sE = (LAS int*)(F.lds + 1024); LAS int* sR = (LAS int*)(F.lds + 2048); LAS float* sG = (LAS float*)(F.lds + 3072); LAS float* sRS = (LAS float*)(F.lds + 4096);
    constexpr int STR = 2080;
    LAS unsigned char* img = F.lds + 8192;
    const int lane = F.lane, w = F.wave, fr = lane & 15, fq = lane >> 4, tid = F.tid;
    __syncthreads();
    for (int p = tid; p < D * NE; p += NWAVES * 64) { const int d = p >> 3, e = p & 7; const float g = gwr[p];
        const unsigned hi = f2bf(g); const float ghi = __builtin_bit_cast(float, hi << 16); const unsigned lo = f2bf(g - ghi);
        *(LAS unsigned short*)(img + e * STR + d * 2) = (unsigned short)hi; *(LAS unsigned short*)(img + (8 + e) * STR + d * 2) = (unsigned short)lo; }
    for (int tile = F.vcu; tile < T / 128; tile += F.G) {
        __syncthreads();
        if (tid < 8) lcnt[tid] = 0;
        __syncthreads();
        const int tlo = w * 16 + fr;
        const bf16* hrow = h + (size_t)(tile * 128 + tlo) * D + 8 * fq;
        v4u A[2][8];
#pragma unroll
        for (int k8 = 0; k8 < 8; ++k8) A[0][k8] = *(const v4u*)(hrow + 32 * k8);
        f32x4 acc = (f32x4){0.f, 0.f, 0.f, 0.f}; float ssl = 0.f;
#pragma unroll
        for (int c = 0; c < 4; ++c) {
            if (c + 1 < 4) {
#pragma unroll
                for (int k8 = 0; k8 < 8; ++k8) A[(c + 1) & 1][k8] = *(const v4u*)(hrow + 32 * (8 * (c + 1) + k8)); }
#pragma unroll
            for (int k8 = 0; k8 < 8; ++k8) { const int ks = 8 * c + k8; const v4u a = A[c & 1][k8];
                const bf16x8 bfrag = *(const LAS bf16x8*)(img + fr * STR + (32 * ks + 8 * fq) * 2);
                acc = __builtin_amdgcn_mfma_f32_16x16x32_bf16(__builtin_bit_cast(bf16x8, a), bfrag, acc, 0, 0, 0);
#pragma unroll
                for (int q = 0; q < 4; ++q) { const unsigned u = a[q]; const float lo = bflo(u), hi = bfhi(u); ssl += lo * lo + hi * hi; } }
            __builtin_amdgcn_sched_barrier(0);
        }
        ssl += __shfl_xor(ssl, 16); ssl += __shfl_xor(ssl, 32);
        const float rso = __builtin_amdgcn_rsqf(ssl * (1.0f / 1024.0f) + EPS);
        if (fq == 0) sRS[tlo] = rso;
#pragma unroll
        for (int jj = 0; jj < 4; ++jj) {
            float v = acc[jj] + __shfl_down(acc[jj], 8);
            if (fr >= 8) v = -3.0e38f;
            float bv = v; int bi = fr;
            RT_STEP(bv, bi, 0xB1); RT_STEP(bv, bi, 0x4E); RT_STEP(bv, bi, 0x141);
            float sv = (fr == bi) ? -3.0e38f : v; int si = fr;
            RT_STEP(sv, si, 0xB1); RT_STEP(sv, si, 0x4E); RT_STEP(sv, si, 0x141);
            if (fr == 0) { const int tl = w * 16 + 4 * fq + jj; const float rs = sRS[tl];
                const float ex = __expf((sv - bv) * rs); const float g0 = 1.0f / (1.0f + ex), g1 = ex / (1.0f + ex);
                const int r0 = __hip_atomic_fetch_add(lcnt + bi, 1, __ATOMIC_RELAXED, __HIP_MEMORY_SCOPE_WORKGROUP), r1 = __hip_atomic_fetch_add(lcnt + si, 1, __ATOMIC_RELAXED, __HIP_MEMORY_SCOPE_WORKGROUP);
                sE[2 * tl] = bi; sE[2 * tl + 1] = si; sR[2 * tl] = r0; sR[2 * tl + 1] = r1; sG[2 * tl] = g0; sG[2 * tl + 1] = g1; }
        }
        __syncthreads();
        if (tid < 8) lbase[tid] = (int)__hip_atomic_fetch_add(gcnt + tid * 64, (unsigned)lcnt[tid], RLX_AGENT);
        __syncthreads();
        if (tid < 128) { const int t = tile * 128 + tid;
#pragma unroll
            for (int k = 0; k < 2; ++k) { const int e = sE[2 * tid + k]; tokE[2 * t + k] = e; tokR[2 * t + k] = lbase[e] + sR[2 * tid + k]; tokG[2 * t + k] = sG[2 * tid + k]; } }
#pragma unroll 4
        for (int tt = 0; tt < 16; ++tt) {
            const int tl = w * 16 + tt, t = tile * 128 + tl;
            const float rs = sRS[tl] * 16.0f;
            const int e0 = sE[2 * tl], e1 = sE[2 * tl + 1];
            const size_t p0 = (size_t)e0 * T + (size_t)(lbase[e0] + sR[2 * tl]), p1 = (size_t)e1 * T + (size_t)(lbase[e1] + sR[2 * tl + 1]);
#pragma unroll
            for (int i = 0; i < 2; ++i) { const v4u hw = *(const v4u*)(h + (size_t)t * D + 8 * lane + 512 * i);
                v2u w8; w8.x = pg8::pk4_fp8(bflo(hw.x) * rs, bfhi(hw.x) * rs, bflo(hw.y) * rs, bfhi(hw.y) * rs); w8.y = pg8::pk4_fp8(bflo(hw.z) * rs, bfhi(hw.z) * rs, bflo(hw.w) * rs, bfhi(hw.w) * rs);
                *(v2u*)(xb + p0 * D + 8 * lane + 512 * i) = w8; *(v2u*)(xb + p1 * D + 8 * lane + 512 * i) = w8; }
        }
    }
}
__device__ __forceinline__ void expert_tiles(Frame& F, int j, int (&tend)[8]) {
    const unsigned* gcnt = F.ctl + CW_GCNT + j * 8 * 64; int acc = 0;
#pragma unroll
    for (int e = 0; e < 8; ++e) { const int c = (int)__builtin_amdgcn_readfirstlane((int)gcnt[e * 64]); acc += (c + 255) >> 8; tend[e] = acc; }
}
__device__ __forceinline__ void cb_phase(Frame& F, int j, int s_next, int part, int lim, int gw, int NGW) {
    bf16* hb = (bf16*)(F.ws + WS_HB); const bf16* ys = (const bf16*)(F.ws + WS_XB); float* out = F.out;
    const int* tokE = (const int*)(F.ws + WS_TOKE); const int* tokR = (const int*)(F.ws + WS_TOKR); const float* tokG = (const float*)(F.ws + WS_TOKG);
    pg8::u64* sumsq = (pg8::u64*)(F.ws + WS_SUMSQ) + (size_t)s_next * T;
    const bool last = (j == 1);
    LAS int* tstart = (LAS int*)(F.lds + 0);
    { int tend[8]; expert_tiles(F, j, tend);
      __syncthreads();
      if (F.tid == 0) { tstart[0] = 0;
#pragma unroll
          for (int e = 1; e < 8; ++e) tstart[e] = tend[e - 1]; }
      __syncthreads(); }
    const int lane = F.lane;
    f32x4 fg[2][2];
#pragma unroll
    for (int i = 0; i < 2; ++i) { const f32x4* fp = (const f32x4*)(F.in[I_FG] + 8 * lane + 512 * i); fg[i][0] = fp[0]; fg[i][1] = fp[1]; }
    for (int tb = gw; tb < T; tb += 2 * NGW) {
        v4u hw[2][2], ya[2][2], yb[2][2]; float g0[2], g1[2]; bool ok[2];
#pragma unroll
        for (int u = 0; u < 2; ++u) { const int t = tb + u * NGW; ok[u] = t < T; const int tt = ok[u] ? t : tb;
            const int p0 = tstart[tokE[2 * tt]] * 256 + tokR[2 * tt], p1 = tstart[tokE[2 * tt + 1]] * 256 + tokR[2 * tt + 1]; g0[u] = tokG[2 * tt]; g1[u] = tokG[2 * tt + 1];
            if (part) { const bool low = (p0 < lim) && (p1 < lim); ok[u] = ok[u] && (part == 1 ? low : !low); }
#pragma unroll
            for (int i = 0; i < 2; ++i) { hw[u][i] = (v4u){0u, 0u, 0u, 0u}; ya[u][i] = (v4u){0u, 0u, 0u, 0u}; yb[u][i] = (v4u){0u, 0u, 0u, 0u}; }
            if (ok[u]) {
#pragma unroll
                for (int i = 0; i < 2; ++i) { hw[u][i] = *(const v4u*)(hb + (size_t)tt * D + 8 * lane + 512 * i); ya[u][i] = *(const v4u*)(ys + (size_t)p0 * D + 8 * lane + 512 * i); yb[u][i] = *(const v4u*)(ys + (size_t)p1 * D + 8 * lane + 512 * i); } } }
#pragma unroll
        for (int u = 0; u < 2; ++u) { const int t = tb + u * NGW;
            float x[2][8]; float ss = 0.f;
#pragma unroll
            for (int i = 0; i < 2; ++i)
#pragma unroll
                for (int q = 0; q < 4; ++q) { const unsigned h_ = hw[u][i][q], a_ = ya[u][i][q], b_ = yb[u][i][q];
                    const float lo = bflo(h_) + g0[u] * bflo(a_) + g1[u] * bflo(b_), hi = bfhi(h_) + g0[u] * bfhi(a_) + g1[u] * bfhi(b_);
                    x[i][2 * q] = lo; x[i][2 * q + 1] = hi; ss += lo * lo + hi * hi; }
            ss = wave_sum(ss);
            if (ok[u]) {
                if (!last) {
#pragma unroll
                    for (int i = 0; i < 2; ++i) { v4u w; w.x = pk2(x[i][0], x[i][1]); w.y = pk2(x[i][2], x[i][3]); w.z = pk2(x[i][4], x[i][5]); w.w = pk2(x[i][6], x[i][7]);
                        *(v4u*)(hb + (size_t)t * D + 8 * lane + 512 * i) = w; }
                    if (lane == 0) sumsq[t] = pg8::ss_to_fx(ss);
                } else {
                    const float rs = __builtin_amdgcn_rsqf(ss * (1.0f / 1024.0f) + EPS);
#pragma unroll
                    for (int i = 0; i < 2; ++i) { f32x4* orow = (f32x4*)(out + (size_t)t * D + 8 * lane + 512 * i);
                        orow[0] = (f32x4){x[i][0], x[i][1], x[i][2], x[i][3]} * rs * fg[i][0]; orow[1] = (f32x4){x[i][4], x[i][5], x[i][6], x[i][7]} * rs * fg[i][1]; }
                }
            }
        }
    }
}

struct Args { const float* in[23]; float* out; unsigned char* ws; int ph_lo, ph_hi, rep_mask, pad; };
__global__ void __launch_bounds__(NWAVES * 64, 2) hymba_fwd(Args args) {
    extern __shared__ __attribute__((aligned(16))) unsigned char lds[];
#define MKFRAME() Frame F; { int t_ = threadIdx.x, bx_ = blockIdx.x, g_ = gridDim.x; asm volatile("" : "+v"(t_)); asm volatile("" : "+s"(bx_)); asm volatile("" : "+s"(g_)); \
        F.lds = (LAS unsigned char*)lds; F.MISC = (volatile LAS unsigned*)(F.lds + MISC_OFF); F.tid = t_; F.lane = t_ & 63; F.wave = __builtin_amdgcn_readfirstlane(t_ >> 6); \
        F.G = g_; F.bx = bx_; F.vcu = (g_ % 8 == 0) ? (bx_ % 8) * (g_ / 8) + bx_ / 8 : bx_; F.ws = args.ws; F.ctl = (unsigned*)(args.ws + WS_CTL); F.out = args.out; F.in = args.in; }
    { MKFRAME();
      for (int u = F.tid; u < (LDS_BYTES - LDSCTL_OFF) / 4; u += NWAVES * 64) ((LAS unsigned*)(F.lds + LDSCTL_OFF))[u] = 0u; }
    __syncthreads();
    const bool one_launch = (args.ph_hi - args.ph_lo) > 1;
    XcdBarrier bar; bar.bar = (unsigned*)(args.ws + WS_CTL) + CW_BAR; bar.x = 0; bar.st = nullptr;
    if (one_launch) bar = xcd_barrier_post((unsigned*)(args.ws + WS_CTL) + CW_BAR, (volatile LAS unsigned*)((LAS unsigned char*)lds + MISC_OFF) + 8);
    const int lo = args.ph_lo, hi = args.ph_hi;
#define IN(k) (lo <= (k) && (k) < hi)
#if REP_MASK
#define REPS(b) for (int rep_ = 0; rep_ <= ((args.rep_mask >> (b)) & 1); ++rep_)
#else
#define REPS(b)
#endif
#define SEAM(k) do { if (IN((k) + 1)) xcd_barrier(bar); } while (0)

    if (DBG_ON(0) && IN(0)) { REPS(0) { MKFRAME(); p0_prologue(F); } SEAM(0); }

    for (int l = 0; l < DEPTH; ++l) {
        const int pb = 1 + (l >> 1) * 13 + (l & 1) * 5, j = l >> 1;
        if (DBG_ON(1) && IN(pb + 0)) { REPS(1) { MKFRAME(); pg8::u64* sumsq = (pg8::u64*)(F.ws + WS_SUMSQ); bf16* hb = (bf16*)(F.ws + WS_HB);
            pg8::Gemm g{hb, (const bf16*)(F.ws + WS_WIN) + (size_t)l * DIN * D, 2 * D, 0, 0}; pg8::Sched S; S.init(T / 256, DIN / 256, F.G, F.bx);
            pg8::EpiMix E{(bf16*)(F.ws + WS_Z), DZ, sumsq + (size_t)(2 * l) * T};
            pg8::gemm_phase<pg8::EpiMix, false, false>(F.lds + RING_OFF, g, S, E, F.tid); }
            SEAM(pb + 0);
        }
        if (DBG_ON(2) && IN(pb + 1)) { REPS(2) { MKFRAME();
            const int bx = F.bx;
            int role, idx, n;
            if (F.G >= 16 && (F.G % 16) == 0) { role = (bx >> 3) & 1; idx = (bx >> 4) * 8 + (bx & 7); n = F.G / 2; }
            else if (F.G >= 2) { role = bx & 1; idx = bx >> 1; n = role ? F.G / 2 : (F.G + 1) / 2; }
            else { role = 2; idx = 0; n = 1; }
            if (role != 1) mix_lru(F, l, idx, n);
            if (role != 0) { mix_conv_a(F, l, idx, n);
                const int half = (NE - P0_EXPERTS) / 2, e_lo = P0_EXPERTS + (l & 1) * half, e_hi = (l & 1) ? NE : e_lo + half; int rot = 0;
                convert_experts_pipe(F, l >> 1, e_lo, e_hi, idx * NWAVES + F.wave, n * NWAVES); } }
            SEAM(pb + 1);
        }
        if (DBG_ON(3) && IN(pb + 2)) { { MKFRAME(); pg8::u64* sumsq = (pg8::u64*)(F.ws + WS_SUMSQ); bf16* hb = (bf16*)(F.ws + WS_HB);
            pg8::Gemm g{(const bf16*)(F.ws + WS_Y), (const bf16*)(F.ws + WS_WOUT) + (size_t)l * D * D, 2 * D, 0, 0}; pg8::Sched S; S.init(T / 256, D / 256, F.G, F.bx);
            pg8::EpiResid E{hb, sumsq + (size_t)(2 * l + 1) * T, (l & 1) ? 0 : 2, F.ws + WS_XB};
            pg8::gemm_phase<pg8::EpiResid, false, false>(F.lds + RING_OFF, g, S, E, F.tid); }
            SEAM(pb + 2);
        }
        if ((l & 1) == 0) {
            if (DBG_ON(4) && IN(pb + 3)) { REPS(4) { MKFRAME(); pg8::u64* sumsq = (pg8::u64*)(F.ws + WS_SUMSQ);
                pg8::Gemm g{F.ws + WS_XB, F.ws + WS_W13 + (size_t)j * (2 * FF) * D, D, 0x7C7C7C7C, 0x79797979}; pg8::Sched S; S.init(T / 256, (2 * FF) / 256, F.G, F.bx);
                pg8::EpiSwiglu8 E{F.ws + WS_U, FF, sumsq + (size_t)(2 * l + 1) * T};
                pg8::gemm_phase<pg8::EpiSwiglu8, false, true>(F.lds + RING_OFF, g, S, E, F.tid); }
                SEAM(pb + 3);
            }
            if (DBG_ON(5) && IN(pb + 4)) { { MKFRAME(); pg8::u64* sumsq = (pg8::u64*)(F.ws + WS_SUMSQ); bf16* hb = (bf16*)(F.ws + WS_HB);
                pg8::Gemm g{F.ws + WS_U, F.ws + WS_W2 + (size_t)j * D * FF, FF, 0x7D7D7D7D, 0x78787878}; pg8::Sched S; S.init(T / 256, D / 256, F.G, F.bx);
                pg8::EpiResid E{hb, sumsq + (size_t)(2 * l + 2) * T, 1, nullptr};
                pg8::gemm_phase<pg8::EpiResid, false, true>(F.lds + RING_OFF, g, S, E, F.tid); }
                SEAM(pb + 4);
            }
        } else {
            if (DBG_ON(6) && IN(pb + 3)) { { MKFRAME(); rt_phase(F, j); } SEAM(pb + 3); }
            if (DBG_ON(8) && IN(pb + 4)) { REPS(8) { MKFRAME();
                pg8::Sched S; { int tend[8]; expert_tiles(F, j, tend); S.init(tend[7], (2 * FFE) / 256, F.G, F.bx);
#pragma unroll
                    for (int e = 0; e < 8; ++e) S.tend[e] = tend[e]; S.estride = (size_t)(2 * FFE) * D; S.ecap = T; }
                pg8::Gemm g{F.ws + WS_XB8S, F.ws + WS_WE13 + (size_t)j * NE * (2 * FFE) * D, D, 0x7B7B7B7B  , 0x79797979  };
                pg8::EpiSwiglu8 E{F.ws + WS_HID, FFE, nullptr};
                pg8::gemm_phase<pg8::EpiSwiglu8, true, true, true>(F.lds + RING_OFF, g, S, E, F.tid); }
                SEAM(pb + 4);
            }
            if (DBG_ON(9) && IN(pb + 5)) { REPS(9) { MKFRAME();
                pg8::Sched S; { int tend[8]; expert_tiles(F, j, tend); S.init(tend[7] < F.G ? tend[7] : F.G, D / 256, F.G, F.bx);
#pragma unroll
                    for (int e = 0; e < 8; ++e) S.tend[e] = tend[e]; S.estride = (size_t)D * FFE; }
                pg8::Gemm g{F.ws + WS_HID, F.ws + WS_WE2 + (size_t)j * NE * D * FFE, FFE, 0x7D7D7D7D  , 0x78787878  };
                pg8::EpiScale E{(bf16*)(F.ws + WS_XB), D, nullptr};
                pg8::gemm_phase<pg8::EpiScale, true, true>(F.lds + RING_OFF, g, S, E, F.tid); }
                SEAM(pb + 5);
            }
            if (DBG_ON(10) && IN(pb + 6)) { { MKFRAME();
                int tend[8]; expert_tiles(F, j, tend);
                const int nM = tend[7], nL = nM > F.G ? nM - F.G : 0, NT = 32;
                if (nL > 0 && F.G > 2 * NT) {
                    if (F.bx < NT) {
                        pg8::Sched S; S.init(nL, D / 256, NT, F.bx);
#pragma unroll
                        for (int e = 0; e < 8; ++e) S.tend[e] = tend[e];
                        S.estride = (size_t)D * FFE; S.pm0 = F.G;
                        pg8::Gemm g{F.ws + WS_HID, F.ws + WS_WE2 + (size_t)j * NE * D * FFE, FFE, 0x7D7D7D7D, 0x78787878};
                        pg8::EpiScale E{(bf16*)(F.ws + WS_XB), D, nullptr};
                        pg8::gemm_phase<pg8::EpiScale, true, true>(F.lds + RING_OFF, g, S, E, F.tid);
                    } else cb_phase(F, j, 2 * l + 2, 1, F.G * 256, (F.bx - NT) * NWAVES + F.wave, (F.G - NT) * NWAVES);
                } else cb_phase(F, j, 2 * l + 2, 0, 0, F.vcu * NWAVES + F.wave, F.G * NWAVES);
                }
                SEAM(pb + 6);
            }
            if (DBG_ON(10) && IN(pb + 7)) { { MKFRAME();
                int tend[8]; expert_tiles(F, j, tend);
                if (tend[7] > F.G && F.G > 64) cb_phase(F, j, 2 * l + 2, 2, F.G * 256, (F.bx >= 32 ? (F.bx - 32) : (F.G - 32 + F.bx)) * NWAVES + F.wave, F.G * NWAVES);
                }
                SEAM(pb + 7);
            }
        }
    }
#undef IN
#undef SEAM
}

extern "C" void kernel_launch(void* const* d_in, const int* in_sizes, int n_in, void* d_out, int out_size, void* d_ws, size_t ws_size, hipStream_t stream) {
    static int grid = 0;
    if (grid == 0) {
        if (n_in != 23 || in_sizes[0] != T * D || out_size != T * D || ws_size < WS_END) {
            fprintf(stderr, "kernel_launch: built for 23 inputs, x/out of %d floats, >= %zu bytes of workspace; got n_in %d, in0 %d, out %d, ws %zu; nothing launched\n", T * D, (size_t)WS_END, n_in, n_in > 0 ? in_sizes[0] : -1, out_size, ws_size);
            grid = -1; return; }
        int dev = 0, cus = 0, per_cu = 0;
        if (hipGetDevice(&dev) != hipSuccess || hipDeviceGetAttribute(&cus, hipDeviceAttributeMultiprocessorCount, dev) != hipSuccess) { fprintf(stderr, "kernel_launch: device query failed\n"); grid = -1; return; }
        if (hipFuncSetAttribute((const void*)hymba_fwd, hipFuncAttributeMaxDynamicSharedMemorySize, LDS_BYTES) != hipSuccess) { fprintf(stderr, "kernel_launch: hipFuncSetAttribute failed\n"); grid = -1; return; }
        if (hipOccupancyMaxActiveBlocksPerMultiprocessor(&per_cu, (const void*)hymba_fwd, NWAVES * 64, LDS_BYTES) != hipSuccess || per_cu < 1)
            fprintf(stderr, "kernel_launch: note: occupancy query reports %d workgroups per CU\n", per_cu);
        (void)hipGetLastError();
        grid = cus;
    }
    if (grid < 0) return;
    if (hipMemsetAsync((char*)d_ws + WS_CTL, 0, CTL_ZERO_BYTES, stream) != hipSuccess) { fprintf(stderr, "kernel_launch: memset failed\n"); return; }
    Args a{};
    for (int i = 0; i < 23; ++i) a.in[i] = (const float*)d_in[i];
    a.out = (float*)d_out; a.ws = (unsigned char*)d_ws; a.rep_mask = REP_MASK;
#if MK_MULTI
    for (int p = 0; p < NPHASE; ++p) { a.ph_lo = p; a.ph_hi = p + 1; hipLaunchKernelGGL(hymba_fwd, dim3(grid), dim3(NWAVES * 64), LDS_BYTES, stream, a); }
#else
    a.ph_lo = 0; a.ph_hi = NPHASE;
    hipLaunchKernelGGL(hymba_fwd, dim3(grid), dim3(NWAVES * 64), LDS_BYTES, stream, a);
#endif
    const hipError_t le = hipPeekAtLastError();
    if (le != hipSuccess) fprintf(stderr, "kernel_launch: launch failed: %s\n", hipGetErrorName(le));
}
```

```cpp
#include <hip/hip_runtime.h>
#include <cstdio>
#include <cstdint>

#ifndef DBG_MASK
#define DBG_MASK 0xFFFF
#endif
#define DBG_ON(b) ((DBG_MASK >> (b)) & 1)
#ifndef REP_MASK
#define REP_MASK 0
#endif
#ifndef MK_MULTI
#define MK_MULTI 0
#endif

namespace pg8 {
#define PG8_LAS __attribute__((address_space(3)))
typedef unsigned short bf16_t;
typedef short bf16x8 __attribute__((ext_vector_type(8)));
typedef float f32x4 __attribute__((ext_vector_type(4)));
typedef unsigned u32x4 __attribute__((ext_vector_type(4)));
constexpr int BM = 256, BK = 64, HALF = 128, HTB = HALF * BK * 2  , STAGE_BYTES = 8 * HTB, NXCD = 8, WGM = 8;
constexpr float RMS_EPS = 1e-6f;
typedef unsigned long long u64;
__device__ __forceinline__ u64 ss_to_fx(float ss) { return (u64)(ss * 1048576.0f + 0.5f); }
__device__ __forceinline__ float fx_to_rs(u64 v) { return __builtin_amdgcn_rsqf((float)v * (1.0f / (1048576.0f * 1024.0f)) + RMS_EPS); }

__host__ __device__ __forceinline__ int lds_byte(int r, int c) { const int st = (r >> 4) * 2 + (c >> 5), rr = r & 15, cc = c & 31, ob = rr * 64 + cc * 2; return st * 1024 + (ob ^ (((ob >> 9) & 1) << 5)); }
__host__ __device__ __forceinline__ void stage_rc(int b, int& R, int& C) { const int st = b / 1024, sb = b % 1024, swz = sb ^ (((sb >> 9) & 1) << 5); R = (st >> 1) * 16 + swz / 64; C = (st & 1) * 32 + (swz % 64) / 2; }
__host__ __device__ __forceinline__ int perm32(int rho) { const int n = rho >> 4, i = rho & 15; return 8 * (i >> 2) + 4 * n + (i & 3); }

struct Unit { int pm, pn; };
struct Gemm { const void* A; const void* Bt; int pitch; int sa, sb; };
typedef int i32x4 __attribute__((ext_vector_type(4)));
typedef int i32x8 __attribute__((ext_vector_type(8)));

struct Sched {
    int nM, nN, nwg, G, c; int tend[8]; size_t estride; int pm0;
    __device__ __forceinline__ void init(int nM_, int nN_, int G_, int c_) { nM = nM_; nN = nN_; nwg = nM * nN; G = G_; c = c_; estride = 0; ecap = 0; pm0 = 0;
#pragma unroll
        for (int e = 0; e < 8; ++e) tend[e] = 0; }
    __device__ __forceinline__ bool next(int i, Unit& u) const {
        const long L = (long)i * G + c; if (L >= nwg) return false;
        int wgid = (int)L; { const int q = nwg / NXCD, r = nwg % NXCD, xcd = wgid % NXCD, off = wgid / NXCD; wgid = (xcd < r ? xcd * (q + 1) : r * (q + 1) + (xcd - r) * q) + off; }
        const int nig = WGM * nN, gid = wgid / nig, fm = gid * WGM, gsz = (nM - fm) < WGM ? (nM - fm) : WGM;
        u.pm = pm0 + fm + ((wgid % nig) % gsz); u.pn = (wgid % nig) / gsz; return true;
    }
    int ecap;
    __device__ __forceinline__ int arow(int pm) const { int e = 0, ts = 0;
#pragma unroll
        for (int k = 0; k < 7; ++k) if (pm >= tend[k]) { e = k + 1; ts = tend[k]; }
        return e * ecap + (pm - ts) * BM; }
    __device__ __forceinline__ int expert(int pm) const { int e = 0;
#pragma unroll
        for (int k = 0; k < 7; ++k) e += (pm >= tend[k]) ? 1 : 0;
        return e; }
};

__device__ __forceinline__ unsigned cvt_pk_bf16(float lo, float hi) { unsigned r; asm volatile("v_cvt_pk_bf16_f32 %0, %1, %2" : "=v"(r) : "v"(lo), "v"(hi)); return r; }

__device__ __forceinline__ unsigned pk4_fp8(float a, float b, float c, float d) {
    a = fminf(fmaxf(a, -448.f), 448.f); b = fminf(fmaxf(b, -448.f), 448.f); c = fminf(fmaxf(c, -448.f), 448.f); d = fminf(fmaxf(d, -448.f), 448.f);
    int w = 0; w = __builtin_amdgcn_cvt_pk_fp8_f32(a, b, w, false); w = __builtin_amdgcn_cvt_pk_fp8_f32(c, d, w, true); return (unsigned)w; }
__device__ __forceinline__ void row_scales8(const u64* sumsq, int row0, float (&rsv)[2][4]) {
    if (sumsq) {
        u64 raw[8];
#pragma unroll
        for (int k = 0; k < 8; ++k) { const u64* p = sumsq + row0 + (k >> 2) * HALF + (k & 3) * 16; asm volatile("global_load_dwordx2 %0, %1, off" : "=v"(raw[k]) : "v"(p)); }
        asm volatile("s_waitcnt vmcnt(0)" : "+v"(raw[0]), "+v"(raw[1]), "+v"(raw[2]), "+v"(raw[3]), "+v"(raw[4]), "+v"(raw[5]), "+v"(raw[6]), "+v"(raw[7]) :: "memory");
#pragma unroll
        for (int k = 0; k < 8; ++k) rsv[k >> 2][k & 3] = fx_to_rs(raw[k]);
    } else {
#pragma unroll
        for (int k = 0; k < 8; ++k) rsv[k >> 2][k & 3] = 1.0f;
    }
}
#define PG8_ZERO(ai, m) do { acc[ai][0][m][0] = (f32x4){0.f, 0.f, 0.f, 0.f}; acc[ai][0][m][1] = (f32x4){0.f, 0.f, 0.f, 0.f}; acc[ai][1][m][0] = (f32x4){0.f, 0.f, 0.f, 0.f}; acc[ai][1][m][1] = (f32x4){0.f, 0.f, 0.f, 0.f}; } while (0)
struct EpiScale {
    static constexpr bool PERM = true;
    bf16_t* O; int ldc; const u64* sumsq;
    __device__ __forceinline__ void operator()(f32x4 (&acc)[2][2][4][2], const Unit& u, int wr, int wc, int fr, int fq) const {
        const int row0 = u.pm * BM + wr * 64 + fr, col0 = u.pn * BM + wc * 32 + 8 * fq;
        float rsv[2][4]; row_scales8(sumsq, row0, rsv);
#pragma unroll
        for (int ai = 0; ai < 2; ++ai)
#pragma unroll
            for (int m = 0; m < 4; ++m) { const int row = row0 + ai * HALF + m * 16; bf16_t* rowp = O + (size_t)row * ldc + col0;
                const float rs = rsv[ai][m];
#pragma unroll
                for (int bj = 0; bj < 2; ++bj) { const f32x4 v0 = acc[ai][bj][m][0] * rs, v1 = acc[ai][bj][m][1] * rs;
                    u32x4 w; w.x = cvt_pk_bf16(v0[0], v0[1]); w.y = cvt_pk_bf16(v0[2], v0[3]); w.z = cvt_pk_bf16(v1[0], v1[1]); w.w = cvt_pk_bf16(v1[2], v1[3]);
                    *(u32x4*)(rowp + bj * HALF) = w; } PG8_ZERO(ai, m); }
    }
};
struct EpiMix {
    static constexpr bool PERM = true;
    bf16_t* O; int ldc; const u64* sumsq;
    __device__ __forceinline__ void operator()(f32x4 (&acc)[2][2][4][2], const Unit& u, int wr, int wc, int fr, int fq) const {
        const int row0 = u.pm * BM + wr * 64 + fr;
        float rsv[2][4]; row_scales8(sumsq, row0, rsv);
        if (u.pn < 4) {
            const int col0 = u.pn * HALF + wc * 32 + 8 * fq;
#pragma unroll
            for (int ai = 0; ai < 2; ++ai)
#pragma unroll
                for (int m = 0; m < 4; ++m) { const int row = row0 + ai * HALF + m * 16; const float r2 = rsv[ai][m] * rsv[ai][m];
                    const f32x4 v0 = acc[ai][0][m][0] * acc[ai][1][m][0] * r2, v1 = acc[ai][0][m][1] * acc[ai][1][m][1] * r2;
                    u32x4 w; w.x = cvt_pk_bf16(v0[0], v0[1]); w.y = cvt_pk_bf16(v0[2], v0[3]); w.z = cvt_pk_bf16(v1[0], v1[1]); w.w = cvt_pk_bf16(v1[2], v1[3]);
                    *(u32x4*)(O + (size_t)row * ldc + col0) = w; PG8_ZERO(ai, m); }
        } else {
            const int col0 = 512 + (u.pn - 4) * BM + wc * 32 + 8 * fq;
#pragma unroll
            for (int ai = 0; ai < 2; ++ai)
#pragma unroll
                for (int m = 0; m < 4; ++m) { const int row = row0 + ai * HALF + m * 16; bf16_t* rowp = O + (size_t)row * ldc + col0; const float rs = rsv[ai][m];
#pragma unroll
                    for (int bj = 0; bj < 2; ++bj) { f32x4 v0 = acc[ai][bj][m][0] * rs, v1 = acc[ai][bj][m][1] * rs;
                        if (u.pn >= 8) {
#pragma unroll
                            for (int q = 0; q < 4; ++q) { const float g0 = v0[q], g1 = v1[q];
                                v0[q] = g0 * __builtin_amdgcn_rcpf(1.0f + __builtin_amdgcn_exp2f(g0 * (-2.3022082f - 0.10294324f * g0 * g0)));
                                v1[q] = g1 * __builtin_amdgcn_rcpf(1.0f + __builtin_amdgcn_exp2f(g1 * (-2.3022082f - 0.10294324f * g1 * g1))); } }
                        u32x4 w; w.x = cvt_pk_bf16(v0[0], v0[1]); w.y = cvt_pk_bf16(v0[2], v0[3]); w.z = cvt_pk_bf16(v1[0], v1[1]); w.w = cvt_pk_bf16(v1[2], v1[3]);
                        *(u32x4*)(rowp + bj * HALF) = w; } PG8_ZERO(ai, m); }
        }
    }
};
struct EpiResid {
    static constexpr bool PERM = true;
    bf16_t* h; u64* sumsq; int mode; unsigned char* h8;
    __device__ __forceinline__ void operator()(f32x4 (&acc)[2][2][4][2], const Unit& u, int wr, int wc, int fr, int fq) const {
        typedef unsigned u32x2 __attribute__((ext_vector_type(2)));
        const int row0 = u.pm * BM + wr * 64 + fr, col0 = u.pn * BM + wc * 32 + 8 * fq;
#pragma unroll
        for (int ai = 0; ai < 2; ++ai) {
            u32x4 hw[4][2];
#pragma unroll
            for (int m = 0; m < 4; ++m)
#pragma unroll
                for (int bj = 0; bj < 2; ++bj) hw[m][bj] = *(const u32x4*)(h + (size_t)(row0 + ai * HALF + m * 16) * 1024 + col0 + bj * HALF);
            float ssm[4];
#pragma unroll
            for (int m = 0; m < 4; ++m) { const int row = row0 + ai * HALF + m * 16; const size_t off = (size_t)row * 1024 + col0;
                float ss = 0.f;
#pragma unroll
                for (int bj = 0; bj < 2; ++bj) {
                    const u32x4 w0 = hw[m][bj];
                    f32x4 h0, h1;
                    h0[0] = __builtin_bit_cast(float, w0.x << 16); h0[1] = __builtin_bit_cast(float, w0.x & 0xffff0000u); h0[2] = __builtin_bit_cast(float, w0.y << 16); h0[3] = __builtin_bit_cast(float, w0.y & 0xffff0000u);
                    h1[0] = __builtin_bit_cast(float, w0.z << 16); h1[1] = __builtin_bit_cast(float, w0.z & 0xffff0000u); h1[2] = __builtin_bit_cast(float, w0.w << 16); h1[3] = __builtin_bit_cast(float, w0.w & 0xffff0000u);
                    h0 += acc[ai][bj][m][0]; h1 += acc[ai][bj][m][1];
                    u32x4 w; w.x = cvt_pk_bf16(h0[0], h0[1]); w.y = cvt_pk_bf16(h0[2], h0[3]); w.z = cvt_pk_bf16(h1[0], h1[1]); w.w = cvt_pk_bf16(h1[2], h1[3]);
                    *(u32x4*)(h + off + bj * HALF) = w;
                    if (mode) ss += (h0[0] * h0[0] + h0[1] * h0[1]) + (h0[2] * h0[2] + h0[3] * h0[3]) + (h1[0] * h1[0] + h1[1] * h1[1]) + (h1[2] * h1[2] + h1[3] * h1[3]);
                    if (mode == 2) { u32x2 w8; w8.x = pk4_fp8(h0[0] * 8.0f, h0[1] * 8.0f, h0[2] * 8.0f, h0[3] * 8.0f); w8.y = pk4_fp8(h1[0] * 8.0f, h1[1] * 8.0f, h1[2] * 8.0f, h1[3] * 8.0f);
                        *(u32x2*)(h8 + off + bj * HALF) = w8; }
                }
                if (mode) { ss += __shfl_xor(ss, 16); ss += __shfl_xor(ss, 32); }
                ssm[m] = ss;
                PG8_ZERO(ai, m);
            }
            if (mode) { const float sel = fq == 0 ? ssm[0] : fq == 1 ? ssm[1] : fq == 2 ? ssm[2] : ssm[3];
                atomicAdd(sumsq + row0 + ai * HALF + fq * 16, ss_to_fx(sel)); }
            asm volatile("" ::: "memory"); }
    }
};
struct EpiSwiglu {
    static constexpr bool PERM = true;
    bf16_t* O; int ldc; const u64* sumsq;
    __device__ __forceinline__ void operator()(f32x4 (&acc)[2][2][4][2], const Unit& u, int wr, int wc, int fr, int fq) const {
        const int row0 = u.pm * BM + wr * 64 + fr, col0 = u.pn * HALF + wc * 32 + 8 * fq;
        float rsv[2][4]; row_scales8(sumsq, row0, rsv);
#pragma unroll
        for (int ai = 0; ai < 2; ++ai)
#pragma unroll
            for (int m = 0; m < 4; ++m) { const int row = row0 + ai * HALF + m * 16;
                const float rs = rsv[ai][m];
                float o[8];
#pragma unroll
                for (int n = 0; n < 2; ++n)
#pragma unroll
                    for (int j = 0; j < 4; ++j) { const float a = acc[ai][0][m][n][j] * rs, b = acc[ai][1][m][n][j] * rs;
                        const float sg = __builtin_amdgcn_rcpf(1.0f + __builtin_amdgcn_exp2f(a * -1.4426950408889634f));
                        o[n * 4 + j] = a * sg * b; }
                u32x4 w; w.x = cvt_pk_bf16(o[0], o[1]); w.y = cvt_pk_bf16(o[2], o[3]); w.z = cvt_pk_bf16(o[4], o[5]); w.w = cvt_pk_bf16(o[6], o[7]);
                *(u32x4*)(O + (size_t)row * ldc + col0) = w; PG8_ZERO(ai, m); }
    }
};

struct EpiSwiglu8 {
    static constexpr bool PERM = true;
    unsigned char* O; int ldc; const u64* sumsq;
    __device__ __forceinline__ void operator()(f32x4 (&acc)[2][2][4][2], const Unit& u, int wr, int wc, int fr, int fq) const {
        typedef unsigned u32x2 __attribute__((ext_vector_type(2)));
        const int row0 = u.pm * BM + wr * 64 + fr, col0 = u.pn * HALF + wc * 32 + 8 * fq;
        float rsv[2][4]; row_scales8(sumsq, row0, rsv);
        unsigned char* const obase = O + (size_t)row0 * ldc + col0; const size_t st16 = (size_t)16 * ldc;
#pragma unroll
        for (int ai = 0; ai < 2; ++ai)
#pragma unroll
            for (int m = 0; m < 4; ++m) { const int row = row0 + ai * HALF + m * 16;
                const float rs = rsv[ai][m];
                float o[8];
#pragma unroll
                for (int n = 0; n < 2; ++n)
#pragma unroll
                    for (int j = 0; j < 4; ++j) { const float a = acc[ai][0][m][n][j] * rs, b = acc[ai][1][m][n][j] * rs;
                        const float r = __builtin_amdgcn_rcpf(__builtin_fmaf(__builtin_amdgcn_exp2f(a), -0.36067376022224085f, -0.36067376022224085f));
                        o[n * 4 + j] = (a * b) * r; }
                u32x2 w; w.x = pk4_fp8(o[0], o[1], o[2], o[3]); w.y = pk4_fp8(o[4], o[5], o[6], o[7]);
                *(u32x2*)(obase + (size_t)(8 * ai + m) * st16) = w; PG8_ZERO(ai, m); }
    }
};

template <class Epi, bool MOE, bool FP8, bool ASPARSE = false>
__device__ __forceinline__ void gemm_phase(PG8_LAS unsigned char* lds, const Gemm g, const Sched& S, const Epi& E, const int tid) {
    const int wid = __builtin_amdgcn_readfirstlane(tid >> 6), lane = tid & 63, wr = wid >> 2, wc = wid & 3, fr = lane & 15, fq = lane >> 4;
    const int P = g.pitch, nt = P / (BK * 2);
    unsigned voffA[2], voffB[2];
#pragma unroll
    for (int i = 0; i < 2; ++i) { int R, C; stage_rc(tid * 16 + i * 8192, R, C); const int Rb = Epi::PERM ? ((R & ~31) + perm32(R & 31)) : R;
        voffA[i] = (unsigned)(R * P + C * 2); voffB[i] = (unsigned)(Rb * P + C * 2); }
    const size_t kstep = (size_t)(BK * 2);
    const size_t hstep = (size_t)HALF * P;
    const size_t tstep = 2 * hstep;
    const unsigned ldsw = (unsigned)wid * 1024u;
    const int aoff = lds_byte(wr * 64 + fr, fq * 8), boff = lds_byte(wc * 32 + fr, fq * 8);
#define PG8_SA(b, h) (((b) * 2 + (h)) * HTB)
#define PG8_SB(b, h) ((4 + (b) * 2 + (h)) * HTB)
#define PG8_STAGE(bufoff, gbase, voff) do { _Pragma("unroll") for (int _i = 0; _i < 2; ++_i) \
        __builtin_amdgcn_global_load_lds((const unsigned*)((const char*)(gbase) + (voff)[_i]), (PG8_LAS unsigned*)(lds + (bufoff) + ldsw + _i * 8192), 16, 0, 0); } while (0)
#define PG8_LDA(dst, b, h) do { _Pragma("unroll") for (int m = 0; m < 4; ++m) _Pragma("unroll") for (int k = 0; k < 2; ++k) dst[m][k] = *(const PG8_LAS bf16x8*)(lds + PG8_SA(b, h) + aoff + m * 2048 + k * 1024); } while (0)
#define PG8_LDB(dst, b, h) do { _Pragma("unroll") for (int n = 0; n < 2; ++n) _Pragma("unroll") for (int k = 0; k < 2; ++k) dst[n][k] = *(const PG8_LAS bf16x8*)(lds + PG8_SB(b, h) + boff + n * 2048 + k * 1024); } while (0)
#define PG8_CAT(x) __builtin_shufflevector(__builtin_bit_cast(i32x4, (x)[0]), __builtin_bit_cast(i32x4, (x)[1]), 0, 1, 2, 3, 4, 5, 6, 7)
#define PG8_MMA(ai, bj, At, Bt) do { __builtin_amdgcn_s_setprio(1); \
        if constexpr (FP8) { _Pragma("unroll") for (int m = 0; m < 4; ++m) _Pragma("unroll") for (int n = 0; n < 2; ++n) \
            asm volatile("v_mfma_scale_f32_16x16x128_f8f6f4 %0, %1, %2, %0, %3, %4 op_sel_hi:[0,0,0]" : "+v"(acc[ai][bj][m][n]) : "v"(PG8_CAT(Bt[n])), "v"(PG8_CAT(At[m])), "v"(sbv), "v"(sav)); } \
        else { _Pragma("unroll") for (int m = 0; m < 4; ++m) _Pragma("unroll") for (int n = 0; n < 2; ++n) _Pragma("unroll") for (int k = 0; k < 2; ++k) \
            acc[ai][bj][m][n] = __builtin_amdgcn_mfma_f32_16x16x32_bf16(Bt[n][k], At[m][k], acc[ai][bj][m][n], 0, 0, 0); } \
        __builtin_amdgcn_s_setprio(0); } while (0)
#define PG8_WAIT_V(n) asm volatile("s_waitcnt vmcnt(" #n ")" ::: "memory")
#define PG8_WAIT_L(n) asm volatile("s_waitcnt lgkmcnt(" #n ")" ::: "memory")
#define PG8_BAR __builtin_amdgcn_s_barrier()
#define PG8_SCHED __builtin_amdgcn_sched_barrier(0)
#define PG8_APTR(u) ((const char*)g.A + (ASPARSE ? (size_t)S.arow((u).pm) * (size_t)P : (size_t)(u).pm * tstep))
#define PG8_BPTR(u) ((const char*)g.Bt + (size_t)(u).pn * tstep + (MOE ? (size_t)S.expert((u).pm) * S.estride : (size_t)0))
    Unit cur, nxt; int ui = 0;
    if (!S.next(0, cur)) return;
    f32x4 acc[2][2][4][2];
#pragma unroll
    for (int a = 0; a < 2; ++a)
#pragma unroll
        for (int b = 0; b < 2; ++b)
#pragma unroll
            for (int m = 0; m < 4; ++m)
#pragma unroll
                for (int n = 0; n < 2; ++n) acc[a][b][m][n] = (f32x4){0.f, 0.f, 0.f, 0.f};
    bf16x8 At[4][2], B0[2][2], B1[2][2];
    const int sav = g.sa, sbv = g.sb;
    const char* cA = PG8_APTR(cur); const char* cB = PG8_BPTR(cur);
    PG8_STAGE(PG8_SB(0, 0), cB, voffB); PG8_STAGE(PG8_SB(0, 1), cB + hstep, voffB); PG8_STAGE(PG8_SA(0, 0), cA, voffA); PG8_STAGE(PG8_SA(0, 1), cA + hstep, voffA);
    if (wr == 1) PG8_BAR;
    PG8_WAIT_V(2); PG8_BAR;
    PG8_STAGE(PG8_SB(1, 0), cB + kstep, voffB); PG8_STAGE(PG8_SA(1, 0), cA + kstep, voffA); PG8_STAGE(PG8_SB(1, 1), cB + hstep + kstep, voffB);
    PG8_WAIT_V(6); PG8_BAR;
    for (;;) {
        const bool has_next = S.next(ui + 1, nxt);
        const char* nA = has_next ? PG8_APTR(nxt) : cA; const char* nB = has_next ? PG8_BPTR(nxt) : cB;
#pragma nounroll
        for (int t = 0; t < nt; t += 2) {
            const bool last = (t == nt - 2);
            const char* a1 = cA + (size_t)(t + 1) * kstep;
            const char* a2 = last ? nA : cA + (size_t)(t + 2) * kstep; const char* b2 = last ? nB : cB + (size_t)(t + 2) * kstep;
            const char* a3 = a2 + kstep; const char* b3 = b2 + kstep;
            PG8_LDB(B0, 0, 0); PG8_LDB(B1, 0, 1); PG8_SCHED; PG8_LDA(At, 0, 0); PG8_STAGE(PG8_SA(1, 1), a1 + hstep, voffA);
            PG8_WAIT_V(8); PG8_WAIT_L(0); PG8_BAR; PG8_MMA(0, 0, At, B0); PG8_MMA(0, 1, At, B1); PG8_BAR; PG8_SCHED;
            PG8_LDA(At, 0, 1); PG8_STAGE(PG8_SB(0, 0), b2, voffB); PG8_STAGE(PG8_SB(0, 1), b2 + hstep, voffB); PG8_STAGE(PG8_SA(0, 0), a2, voffA);
            PG8_WAIT_V(8); PG8_WAIT_L(0); PG8_BAR; PG8_MMA(1, 0, At, B0); PG8_MMA(1, 1, At, B1); PG8_BAR; PG8_SCHED;
            PG8_LDB(B0, 1, 0); PG8_LDB(B1, 1, 1); PG8_SCHED; PG8_LDA(At, 1, 0); PG8_STAGE(PG8_SA(0, 1), a2 + hstep, voffA);
            PG8_WAIT_V(8); PG8_WAIT_L(0); PG8_BAR; PG8_MMA(0, 0, At, B0); PG8_MMA(0, 1, At, B1); PG8_BAR; PG8_SCHED;
            PG8_LDA(At, 1, 1); PG8_STAGE(PG8_SB(1, 0), b3, voffB); PG8_STAGE(PG8_SB(1, 1), b3 + hstep, voffB); PG8_STAGE(PG8_SA(1, 0), a3, voffA);
            PG8_WAIT_V(8); PG8_WAIT_L(0); PG8_BAR; PG8_MMA(1, 0, At, B0); PG8_MMA(1, 1, At, B1); PG8_BAR; PG8_SCHED;
        }
        if constexpr (FP8) asm volatile("s_nop 15\n\ts_nop 15" ::: "memory");
        if (wr == 0) PG8_BAR;
        E(acc, cur, wr, wc, fr, fq);
        if (!has_next) break;
        cur = nxt; cA = nA; cB = nB; ++ui;
        if (wr == 1) PG8_BAR;
    }
    PG8_WAIT_V(0);
    PG8_BAR;
#undef PG8_SA
#undef PG8_SB
#undef PG8_STAGE
#undef PG8_LDA
#undef PG8_LDB
#undef PG8_MMA
#undef PG8_CAT
#undef PG8_WAIT_V
#undef PG8_WAIT_L
#undef PG8_BAR
#undef PG8_SCHED
#undef PG8_BPTR
#undef PG8_APTR
}
}

constexpr int NWAVES = 8;
constexpr int D = 1024, BATCH = 16, SEQ = 2048, T = BATCH * SEQ, DEPTH = 4;
constexpr int DCONV = 512, DLRU = 512, DIN = 2560, HD = 64, NHEAD = 8;
constexpr int DZ = 2048;
constexpr int FF = 3072, NE = 8, FFE = 3584;
constexpr int CAP = 2 * T + NE * 256;
constexpr float EPS = 1e-6f;
constexpr int NPHASE = 27;
constexpr float W1SCALE = 64.0f * -1.4426950408889634f;
constexpr int P0_EXPERTS = 0;

constexpr size_t MiB = 1u << 20;
constexpr size_t WS_CTL = 0, CTL_ZERO_BYTES = 7 * MiB / 2;
constexpr size_t WS_SUMSQ = 1 * MiB;
constexpr size_t WS_GWR = 4 * MiB;
constexpr size_t WS_TOKE = 5 * MiB, WS_TOKR = WS_TOKE + 256 * 1024, WS_TOKG = WS_TOKR + 256 * 1024, WS_TOKRS = WS_TOKG + 256 * 1024, WS_TOKPOS = WS_TOKRS + 128 * 1024;
constexpr size_t WS_WIN = 8 * MiB;
constexpr size_t WS_WOUT = WS_WIN + 20 * MiB;
constexpr size_t WS_W13 = WS_WOUT + 8 * MiB;
constexpr size_t WS_W2 = WS_W13 + 24 * MiB;
constexpr size_t WS_WE13 = WS_W2 + 12 * MiB;
constexpr size_t WS_WE2 = WS_WE13 + 112 * MiB;
constexpr size_t WS_HB = WS_WE2 + 56 * MiB;
constexpr size_t WS_XB = WS_HB + 64 * MiB;
constexpr size_t WS_BIG = WS_XB + 132 * MiB;
constexpr size_t WS_Z = WS_BIG, WS_Y = WS_BIG + 160 * MiB, WS_U = WS_BIG, WS_HID = WS_BIG + 231 * MiB;
constexpr size_t WS_XB8S = WS_XB;

constexpr size_t WS_END = WS_BIG + 462 * MiB;
static_assert(WS_XB8S + (size_t)NE * T * D <= WS_HID && WS_HID + (size_t)CAP * FFE <= WS_END, "MoE buffers");
static_assert(WS_WE13 == 72 * MiB && WS_HB == 240 * MiB && WS_BIG == 436 * MiB && WS_END == 898 * MiB, "ws map");
static_assert((size_t)CAP * 1024 * 2 == 132 * MiB && (size_t)CAP * FFE * 2 == 462 * MiB, "cap");
constexpr int CW_TMO = 0;
constexpr int CW_BAR = 4096;
constexpr int CW_GCNT = 8192;

constexpr int RING_OFF = 0, RING_BYTES = 131072;
constexpr int LDS_BYTES = 147456;
constexpr int LDSCTL_OFF = LDS_BYTES - 1024, MISC_OFF = LDSCTL_OFF + 320;
constexpr int MX_STRIDE = 144;
constexpr int MX_XRW = 35 * MX_STRIDE;
constexpr int MX_XR = 0, MX_GR = 8 * MX_XRW, MX_CB = MX_GR + 36864, MX_TOT = MX_CB + 36864, MX_CW = MX_TOT + 2 * 4096, MX_WT = MX_CW + 1280, MX_END = MX_WT + 128 * MX_STRIDE;
static_assert(MX_END <= LDSCTL_OFF && (MX_WT % 16) == 0 && (MX_GR % 16) == 0, "mixer LDS");

#define GAS __attribute__((address_space(1)))
#define LAS __attribute__((address_space(3)))
typedef unsigned short bf16;
typedef unsigned v4u __attribute__((ext_vector_type(4)));
typedef unsigned v2u __attribute__((ext_vector_type(2)));
typedef float f32x4 __attribute__((ext_vector_type(4)));
typedef short bf16x8 __attribute__((ext_vector_type(8)));
typedef GAS unsigned gu32;
typedef float f32x2 __attribute__((ext_vector_type(2)));
#define RLX_AGENT __ATOMIC_RELAXED, __HIP_MEMORY_SCOPE_AGENT
#define LDS_WAIT() asm volatile("s_waitcnt lgkmcnt(0)" ::: "memory")
#define LDS_SYNC() asm volatile("s_waitcnt lgkmcnt(0)\n\ts_barrier" ::: "memory")
__device__ __forceinline__ unsigned f2bf(float f) { unsigned u = __builtin_bit_cast(unsigned, f); return (u + 0x7fffu + ((u >> 16) & 1u)) >> 16; }
__device__ __forceinline__ unsigned pk2(float lo, float hi) { return pg8::cvt_pk_bf16(lo, hi); }
__device__ __forceinline__ float bflo(unsigned w) { return __builtin_bit_cast(float, w << 16); }
__device__ __forceinline__ float bfhi(unsigned w) { return __builtin_bit_cast(float, w & 0xffff0000u); }
__device__ __forceinline__ float row_sum16(float v) {
    v += __builtin_bit_cast(float, __builtin_amdgcn_update_dpp(0, __builtin_bit_cast(int, v), 0xB1, 0xF, 0xF, false));
    v += __builtin_bit_cast(float, __builtin_amdgcn_update_dpp(0, __builtin_bit_cast(int, v), 0x4E, 0xF, 0xF, false));
    v += __builtin_bit_cast(float, __builtin_amdgcn_update_dpp(0, __builtin_bit_cast(int, v), 0x141, 0xF, 0xF, false));
    v += __builtin_bit_cast(float, __builtin_amdgcn_update_dpp(0, __builtin_bit_cast(int, v), 0x140, 0xF, 0xF, false));
    return v;
}
__device__ __forceinline__ float wave_sum(float v) {
    v = row_sum16(v); v += __shfl_xor(v, 16); v += __shfl_xor(v, 32);
    return v;
}

#define XB_TMO      128
#define XB_XCNT(j)  (256  + 64 * (j))
#define XB_XSUB(j)  (1280 + 64 * (j))
#define XB_XGEN(j)  (2304 + 64 * (j))
#define XB_TOP      3328
#define XB_TOPGEN   3392
#define XCD_BAR_WORDS 3456
#define XB_SPIN_CAP (1u << 18)

__device__ __forceinline__ unsigned xb_ld(unsigned* p)              { return __hip_atomic_load(p, __ATOMIC_RELAXED, __HIP_MEMORY_SCOPE_AGENT); }
__device__ __forceinline__ unsigned xb_add(unsigned* p, unsigned v) { return __hip_atomic_fetch_add(p, v, __ATOMIC_RELAXED, __HIP_MEMORY_SCOPE_AGENT); }
__device__ __forceinline__ unsigned xb_xcc_id() { return (unsigned)__builtin_amdgcn_s_getreg((3 << 11) | 20) & 0xFu; }
#define XB_SPIN(cond, bar) do { unsigned _sp = 0; while (cond) { __builtin_amdgcn_s_sleep(1); \
    if ((++_sp & 255u) == 0u) { if (xb_ld(&(bar)[XB_TMO])) break; if (_sp > XB_SPIN_CAP) { atomicAdd(&(bar)[XB_TMO], 1u); break; } } } } while (0)

struct XcdBarrier {
    unsigned* bar; unsigned x;
    volatile LAS unsigned* st;
};

__device__ __forceinline__ XcdBarrier xcd_barrier_post(unsigned* bar, volatile LAS unsigned* st) {
    XcdBarrier b; b.bar = bar; b.x = xb_xcc_id(); b.st = st;
    if (threadIdx.x == 0) (void)xb_add(&bar[XB_XCNT(b.x)], 1u);
    return b;
}
__device__ __forceinline__ void xcd_barrier_complete(unsigned* bar, unsigned x, unsigned& nloc, unsigned& nx) {
    const unsigned G = gridDim.x * gridDim.y * gridDim.z;
    unsigned sum, cnt, mine, sp = 0u;
    for (;;) {
        sum = 0u; cnt = 0u; mine = 0u;
#pragma unroll
        for (unsigned j = 0; j < 16; ++j) { const unsigned c = xb_ld(&bar[XB_XCNT(j)]); sum += c; cnt += (c > 0u) ? 1u : 0u; mine = (j == x) ? c : mine; }
        if (sum == G) break;
        __builtin_amdgcn_s_sleep(1);
        if ((++sp & 255u) == 0u) { if (xb_ld(&bar[XB_TMO])) break; if (sp > XB_SPIN_CAP) { atomicAdd(&bar[XB_TMO], 1u); break; } }
    }
    nloc = mine > 0u ? mine : 1u; nx = cnt > 0u ? cnt : 1u;
}

__device__ __forceinline__ void xcd_barrier(const XcdBarrier& b) {
    asm volatile("s_waitcnt vmcnt(0)" ::: "memory");
    __syncthreads();
    if (threadIdx.x == 0) {
        unsigned* bar = b.bar;
        __builtin_amdgcn_s_waitcnt(0);
        unsigned nloc = b.st[0], nx = b.st[1];
        if (nloc == 0u) { xcd_barrier_complete(bar, b.x, nloc, nx); b.st[0] = nloc; b.st[1] = nx; }
        const unsigned old = xb_add(&bar[XB_XSUB(b.x)], 1u);
        const unsigned gen = old / nloc;
        if (old + 1u == (gen + 1u) * nloc) {
            __builtin_amdgcn_fence(__ATOMIC_RELEASE, "agent");
            asm volatile("s_waitcnt vmcnt(0)" ::: "memory");
            const unsigned og = xb_add(&bar[XB_TOP], 1u);
            const unsigned tg = og / nx;
            if (og + 1u == (tg + 1u) * nx) xb_add(&bar[XB_TOPGEN], 1u);
            else XB_SPIN(xb_ld(&bar[XB_TOPGEN]) == tg, bar);
            __builtin_amdgcn_fence(__ATOMIC_ACQUIRE, "agent");
            xb_add(&bar[XB_XGEN(b.x)], 1u);
            asm volatile("s_waitcnt vmcnt(0)" ::: "memory");
        } else {
            XB_SPIN(xb_ld(&bar[XB_XGEN(b.x)]) == gen, bar);
            __builtin_amdgcn_fence(__ATOMIC_ACQUIRE, "agent");
            asm volatile("s_waitcnt vmcnt(0)" ::: "memory");
        }
    }
    __syncthreads();
}

struct Frame {
    LAS unsigned char* lds;
    volatile LAS unsigned* MISC;
    unsigned* ctl;
    int tid, lane, wave;
    int vcu, G, bx;
    unsigned char* ws;
    const float* const* in;
    float* out;
};
enum { I_X = 0, I_NMG, I_WIN, I_CAW, I_CAB, I_CBW, I_CBB, I_LWR, I_LBR, I_LWI, I_LBI, I_LAM, I_MOG, I_WOUT, I_NFG, I_FW1, I_FW3, I_FW2, I_RW, I_EW1, I_EW3, I_EW2, I_FG };

__device__ __forceinline__ void transpose_load(const float* W, int N, int item, int lane, f32x4 (&v)[16]) {
    const int nblk = N / 64, kb = item / nblk, nb = item % nblk, kq = lane >> 4, nq = lane & 15;
    const f32x4* src = (const f32x4*)(W + (size_t)(64 * kb + 16 * kq) * N + 64 * nb + 4 * nq);
#pragma unroll
    for (int i = 0; i < 16; ++i) v[i] = src[(size_t)i * (N / 4)];
}
template <bool FP8>
__device__ __forceinline__ void transpose_finish(f32x4 (&v)[16], int K, int N, void* WTv, const float* gain, float mul, int mode, int item, int lane) {
    const int nblk = N / 64, kb = item / nblk, nb = item % nblk, kq = lane >> 4, nq = lane & 15;
    const int kbase = 64 * kb + 16 * kq, nbase = 64 * nb + 4 * nq;
    if (gain) { const f32x4* gp = (const f32x4*)(gain + kbase);
#pragma unroll
        for (int q4 = 0; q4 < 4; ++q4) { const f32x4 g4 = gp[q4] * mul;
#pragma unroll
            for (int t = 0; t < 4; ++t) v[4 * q4 + t] = v[4 * q4 + t] * g4[t]; } }
    else {
#pragma unroll
        for (int i = 0; i < 16; ++i) v[i] = v[i] * mul; }
#pragma unroll
    for (int q = 0; q < 4; ++q) { const int nn = nbase + q;
        const int dr = (mode == 0) ? nn : (mode == 3) ? (nn < 512 ? 256 * (nn >> 7) + (nn & 127) : nn < 1024 ? nn + 512 : nn < 1536 ? 256 * ((nn - 1024) >> 7) + 128 + (nn & 127) : nn)
                                   : (256 * (nn >> 7) + (nn & 127) + (mode == 2 ? 128 : 0));
        if constexpr (FP8) { v4u o; o.x = pg8::pk4_fp8(v[0][q], v[1][q], v[2][q], v[3][q]); o.y = pg8::pk4_fp8(v[4][q], v[5][q], v[6][q], v[7][q]);
            o.z = pg8::pk4_fp8(v[8][q], v[9][q], v[10][q], v[11][q]); o.w = pg8::pk4_fp8(v[12][q], v[13][q], v[14][q], v[15][q]);
            *(v4u*)((unsigned char*)WTv + (size_t)dr * K + kbase) = o; }
        else { v4u o0, o1; o0.x = pk2(v[0][q], v[1][q]); o0.y = pk2(v[2][q], v[3][q]); o0.z = pk2(v[4][q], v[5][q]); o0.w = pk2(v[6][q], v[7][q]);
            o1.x = pk2(v[8][q], v[9][q]); o1.y = pk2(v[10][q], v[11][q]); o1.z = pk2(v[12][q], v[13][q]); o1.w = pk2(v[14][q], v[15][q]);
            v4u* dst = (v4u*)((bf16*)WTv + (size_t)dr * K + kbase); dst[0] = o0; dst[1] = o1; } }
}
template <bool FP8>
__device__ __forceinline__ void transpose_item(const float* W, int K, int N, void* WTv, const float* gain, float mul, int mode, int item, int lane) {
    f32x4 v[16]; transpose_load(W, N, item, lane, v); transpose_finish<FP8>(v, K, N, WTv, gain, mul, mode, item, lane);
}
template <bool FP8>
__device__ __forceinline__ void convert_matrix(Frame& F, const float* W, int K, int N, void* WT, const float* gain, float mul, int mode, int& rot, int gw, int NGW) {
    const int nitems = (K / 64) * (N / 64);
    int first = gw - rot; if (first < 0) first += NGW;
    for (int it = first; it < nitems; it += NGW) transpose_item<FP8>(W, K, N, WT, gain, mul, mode, it, F.lane);
    rot = (rot + nitems) % NGW;
}
__device__ __forceinline__ void convert_experts(Frame& F, int j, int e_lo, int e_hi, int& rot, int gw, int NGW) {
    const float* g = F.in[I_NFG] + (size_t)(2 * j + 1) * D;
    for (int e = e_lo; e < e_hi; ++e) {
        const size_t eo = ((size_t)j * NE + e) * (size_t)D * FFE;
        unsigned char* w13 = F.ws + WS_WE13 + ((size_t)j * NE + e) * (size_t)(2 * FFE) * D;
        convert_matrix<true>(F, F.in[I_EW1] + eo, D, FFE, w13, g, W1SCALE, 1, rot, gw, NGW);
        convert_matrix<true>(F, F.in[I_EW3] + eo, D, FFE, w13, g, 64.0f, 2, rot, gw, NGW);
        convert_matrix<true>(F, F.in[I_EW2] + eo, FFE, D, F.ws + WS_WE2 + ((size_t)j * NE + e) * (size_t)D * FFE, nullptr, 128.0f, 0, rot, gw, NGW);
    }
}
struct XItem { const float* W; unsigned char* WT; const float* gain; float mul; int K, N, mode, item; };
__device__ __forceinline__ XItem xitem(Frame& F, int j, int e_lo, int g) {
    constexpr int IPM = (D / 64) * (FFE / 64);
    const int e = e_lo + g / (3 * IPM), r = g % (3 * IPM), mat = r / IPM;
    const size_t eo = ((size_t)j * NE + e) * (size_t)D * FFE;
    XItem x; x.item = r % IPM;
    if (mat < 2) { x.W = F.in[mat == 0 ? I_EW1 : I_EW3] + eo; x.WT = F.ws + WS_WE13 + ((size_t)j * NE + e) * (size_t)(2 * FFE) * D; x.gain = F.in[I_NFG] + (size_t)(2 * j + 1) * D; x.mul = (mat == 0) ? W1SCALE : 64.0f; x.K = D; x.N = FFE; x.mode = 1 + mat; }
    else { x.W = F.in[I_EW2] + eo; x.WT = F.ws + WS_WE2 + ((size_t)j * NE + e) * (size_t)D * FFE; x.gain = nullptr; x.mul = 128.0f; x.K = FFE; x.N = D; x.mode = 0; }
    return x;
}
__device__ __forceinline__ void convert_experts_pipe(Frame& F, int j, int e_lo, int e_hi, int gw, int NGW) {
    constexpr int IPM = (D / 64) * (FFE / 64);
    const int total = (e_hi - e_lo) * 3 * IPM;
    for (int g = gw; g < total; g += NGW) { f32x4 va[16]; const XItem xa = xitem(F, j, e_lo, g); transpose_load(xa.W, xa.N, xa.item, F.lane, va);
        transpose_finish<true>(va, xa.K, xa.N, xa.WT, xa.gain, xa.mul, xa.mode, xa.item, F.lane); }
}
__device__ __forceinline__ void p0_prologue(Frame& F) {
    int rot = 0; const int gw0 = F.vcu * NWAVES + F.wave, NGW0 = F.G * NWAVES;
    for (int l = 0; l < DEPTH; ++l) {
        convert_matrix<false>(F, F.in[I_WIN] + (size_t)l * D * DIN, D, DIN, (bf16*)(F.ws + WS_WIN) + (size_t)l * DIN * D, F.in[I_NMG] + l * D, 1.0f, 3, rot, gw0, NGW0);
        convert_matrix<false>(F, F.in[I_WOUT] + (size_t)l * D * D, D, D, (bf16*)(F.ws + WS_WOUT) + (size_t)l * D * D, F.in[I_MOG] + l * D, 1.0f, 0, rot, gw0, NGW0);
    }
    for (int dj = 0; dj < 2; ++dj) {
        unsigned char* w13 = F.ws + WS_W13 + (size_t)dj * (2 * FF) * D;
        convert_matrix<true>(F, F.in[I_FW1] + (size_t)dj * D * FF, D, FF, w13, F.in[I_NFG] + 2 * dj * D, W1SCALE, 1, rot, gw0, NGW0);
        convert_matrix<true>(F, F.in[I_FW3] + (size_t)dj * D * FF, D, FF, w13, F.in[I_NFG] + 2 * dj * D, 64.0f, 2, rot, gw0, NGW0);
        convert_matrix<true>(F, F.in[I_FW2] + (size_t)dj * FF * D, FF, D, F.ws + WS_W2 + (size_t)dj * D * FF, nullptr, 128.0f, 0, rot, gw0, NGW0);
    }
    convert_experts(F, 0, 0, P0_EXPERTS, rot, gw0, NGW0); convert_experts(F, 1, 0, P0_EXPERTS, rot, gw0, NGW0);
    { float* gwr = (float*)(F.ws + WS_GWR);
      for (int i = F.bx * (NWAVES * 64) + F.tid; i < 2 * D * NE; i += F.G * NWAVES * 64) { const int j = i / (D * NE), d = (i / NE) % D;
          gwr[i] = F.in[I_RW][i] * F.in[I_NFG][(2 * j + 1) * D + d]; } }
    { const int gw = F.vcu * NWAVES + F.wave, NGW = F.G * NWAVES; pg8::u64* sumsq = (pg8::u64*)(F.ws + WS_SUMSQ); bf16* hb = (bf16*)(F.ws + WS_HB);
      for (int mb = gw; mb < T; mb += 4 * NGW) {
          f32x4 v[4][4];
#pragma unroll
          for (int u = 0; u < 4; ++u) { const int m = (mb + u * NGW < T) ? mb + u * NGW : mb; const f32x4* xr = (const f32x4*)(F.in[I_X] + (size_t)m * D) + F.lane;
#pragma unroll
              for (int i = 0; i < 4; ++i) v[u][i] = xr[64 * i]; }
#pragma unroll
          for (int u = 0; u < 4; ++u) { const int m = mb + u * NGW; if (m < T) { v2u* o8 = (v2u*)(hb + (size_t)m * D) + F.lane; float s = 0.f;
#pragma unroll
              for (int i = 0; i < 4; ++i) { const f32x4 x = v[u][i]; s += (x.x * x.x + x.y * x.y) + (x.z * x.z + x.w * x.w); v2u w; w.x = pk2(x.x, x.y); w.y = pk2(x.z, x.w); o8[64 * i] = w; }
              s = wave_sum(s); if (F.lane == 0) sumsq[m] = pg8::ss_to_fx(s); } } } }
}

__device__ __forceinline__ void mix_conv_a(Frame& F, int l, int idx, int nwg) {
    const bf16* z = (const bf16*)(F.ws + WS_Z); bf16* y = (bf16*)(F.ws + WS_Y);
    const int c0 = 8 * F.lane;
    float w0[8], w1[8], w2[8], bs[8];
    { const float* cw = F.in[I_CAW] + (size_t)l * 3 * DCONV; const float* cb = F.in[I_CAB] + (size_t)l * DCONV;
#pragma unroll
      for (int q = 0; q < 8; ++q) { w0[q] = cw[c0 + q]; w1[q] = cw[DCONV + c0 + q]; w2[q] = cw[2 * DCONV + c0 + q]; bs[q] = cb[c0 + q]; } }
    for (int it = idx * NWAVES + F.wave; it < T / 32; it += nwg * NWAVES) {
        const int t0 = it * 32;
        float v1[8], v2[8];
#pragma unroll
        for (int q = 0; q < 8; ++q) { v1[q] = 0.f; v2[q] = 0.f; }
        if ((t0 % SEQ) != 0) {
            const v4u q2 = *(const v4u*)(z + (size_t)(t0 - 2) * DZ + c0), q1 = *(const v4u*)(z + (size_t)(t0 - 1) * DZ + c0);
#pragma unroll
            for (int q = 0; q < 4; ++q) { v2[2 * q] = bflo(q2[q]); v2[2 * q + 1] = bfhi(q2[q]); v1[2 * q] = bflo(q1[q]); v1[2 * q + 1] = bfhi(q1[q]); }
        }
#pragma unroll 8
        for (int tt = 0; tt < 32; ++tt) {
            const size_t t = (size_t)(t0 + tt);
            const v4u vv = *(const v4u*)(z + t * DZ + c0), gb = *(const v4u*)(z + t * DZ + DCONV + c0);
            float v[8], ya[8]; float ss = 0.f;
#pragma unroll
            for (int q = 0; q < 4; ++q) { v[2 * q] = bflo(vv[q]); v[2 * q + 1] = bfhi(vv[q]); }
#pragma unroll
            for (int q = 0; q < 8; ++q) { const float ca = bs[q] + w0[q] * v2[q] + w1[q] * v1[q] + w2[q] * v[q];
                const float g = (q & 1) ? bfhi(gb[q >> 1]) : bflo(gb[q >> 1]); ya[q] = g * ca; ss += ya[q] * ya[q]; v2[q] = v1[q]; v1[q] = v[q]; }
            ss += __builtin_bit_cast(float, __builtin_amdgcn_update_dpp(0, __builtin_bit_cast(int, ss), 0xB1, 0xF, 0xF, false));
            ss += __builtin_bit_cast(float, __builtin_amdgcn_update_dpp(0, __builtin_bit_cast(int, ss), 0x4E, 0xF, 0xF, false));
            ss += __builtin_bit_cast(float, __builtin_amdgcn_update_dpp(0, __builtin_bit_cast(int, ss), 0x141, 0xF, 0xF, false));
            const float sc = __builtin_amdgcn_rsqf(ss * (1.0f / 64.0f) + EPS);
            v4u o; o.x = pk2(ya[0] * sc, ya[1] * sc); o.y = pk2(ya[2] * sc, ya[3] * sc); o.z = pk2(ya[4] * sc, ya[5] * sc); o.w = pk2(ya[6] * sc, ya[7] * sc);
            *(v4u*)(y + t * D + c0) = o;
        }
    }
}

__device__ __forceinline__ float lane_even(float v) { const unsigned u = __builtin_bit_cast(unsigned, v); auto r = __builtin_amdgcn_permlane16_swap(u, u, false, false); const unsigned t = r[0]; return __builtin_bit_cast(float, t); }
__device__ __forceinline__ float lane_row1(float v) { const unsigned u = __builtin_bit_cast(unsigned, v); auto r = __builtin_amdgcn_permlane32_swap(u, u, false, false); const unsigned z = r[0]; auto q = __builtin_amdgcn_permlane16_swap(z, z, false, false); const unsigned t = q[1]; return __builtin_bit_cast(float, t); }
__device__ __forceinline__ float lane_row3(float v) { const unsigned u = __builtin_bit_cast(unsigned, v); auto r = __builtin_amdgcn_permlane32_swap(u, u, false, false); const unsigned z = r[1]; auto q = __builtin_amdgcn_permlane16_swap(z, z, false, false); const unsigned t = q[1]; return __builtin_bit_cast(float, t); }
__device__ __forceinline__ void mix_lru(Frame& F, int l, int idx, int nwg) {
    const bf16* z = (const bf16*)(F.ws + WS_Z); bf16* y = (bf16*)(F.ws + WS_Y);
    LAS unsigned char* lds = F.lds;
    const int lane = F.lane, w = F.wave, fr = lane & 15, fq = lane >> 4, tid = F.tid;
    bf16x8 Iden[2];
#pragma unroll
    for (int par = 0; par < 2; ++par) { v4u q = (v4u){0u, 0u, 0u, 0u};
        if (fq == 2 * par + (fr >> 3)) { const int j = fr & 7; const unsigned one = 0x3F80u << (16 * (j & 1));
            q.x = (j >> 1) == 0 ? one : 0u; q.y = (j >> 1) == 1 ? one : 0u; q.z = (j >> 1) == 2 ? one : 0u; q.w = (j >> 1) == 3 ? one : 0u; }
        Iden[par] = __builtin_bit_cast(bf16x8, q); }
    const int rq = lane >> 3, pcg = lane & 7;
    LAS unsigned char* xrw = lds + MX_XR + w * MX_XRW;
    for (int u = idx; u < BATCH * NHEAD; u += nwg) {
        const int b = u >> 3, hh = u & 7;
        const bf16* zx = z + (size_t)(b * SEQ + 32 * w) * DZ + 2 * DCONV + hh * HD + 8 * pcg;
        LDS_SYNC();
        if (tid < 320) { const int k = tid >> 6, c = tid & 63;
            ((LAS float*)(lds + MX_CW))[tid] = (k < 4) ? F.in[I_CBW][((size_t)l * 4 + k) * DLRU + hh * HD + c] : F.in[I_CBB][(size_t)l * DLRU + hh * HD + c]; }
        { const float* wr_ = F.in[I_LWR] + ((size_t)l * NHEAD + hh) * HD * HD; const float* wi_ = F.in[I_LWI] + ((size_t)l * NHEAD + hh) * HD * HD;
          for (int p = tid; p < 128 * 8; p += NWAVES * 64) { const int col = p >> 3, kc = p & 7, e = col & 63; const float* src = (col < 64 ? wr_ : wi_) + (size_t)(8 * kc) * HD + e;
              const float nl2 = -1.4426950408889634f;
              v4u o; o.x = pk2(src[0] * nl2, src[HD] * nl2); o.y = pk2(src[2 * HD] * nl2, src[3 * HD] * nl2); o.z = pk2(src[4 * HD] * nl2, src[5 * HD] * nl2); o.w = pk2(src[6 * HD] * nl2, src[7 * HD] * nl2);
              *(LAS v4u*)(lds + MX_WT + col * MX_STRIDE + kc * 16) = o; } }
        LDS_SYNC();
        float cbr[4], cbi[4], ck2[4], Hs[4];
#pragma unroll
        for (int n = 0; n < 4; ++n) { const int c = l * DLRU + hh * HD + 16 * n + fr;
            cbr[n] = F.in[I_LBR][c] * -1.4426950408889634f; cbi[n] = F.in[I_LBI][c] * -1.4426950408889634f;
            const float lam = F.in[I_LAM][c]; const float sp = (lam > 20.f) ? __expf(-lam) : log1pf(expf(-lam));
            ck2[n] = -8.0f * sp * 1.4426950408889634f; Hs[n] = 0.f; }
        v4u px[4], pg[4], ph;
#pragma unroll
        for (int i = 0; i < 4; ++i) { const bf16* src = zx + (size_t)(rq + 8 * i) * DZ; px[i] = *(const v4u*)src; pg[i] = *(const v4u*)(src + DLRU); }
        { unsigned z0 = 0u; asm volatile("" : "+v"(z0)); ph = (v4u){z0, z0, z0, z0}; if (lane < 24 && w > 0) ph = *(const v4u*)(zx + ((long)rq - 3) * DZ); }
        for (int ck = 0; ck < SEQ / 256; ++ck) {
            const int tok0 = b * SEQ + ck * 256;
#pragma unroll
            for (int i = 0; i < 4; ++i) { *(LAS v4u*)(xrw + (3 + rq + 8 * i) * MX_STRIDE + pcg * 16) = px[i]; *(LAS v4u*)(lds + MX_GR + (32 * w + rq + 8 * i) * MX_STRIDE + pcg * 16) = pg[i]; }
            if (lane < 24) *(LAS v4u*)(xrw + rq * MX_STRIDE + pcg * 16) = ph;
            if (ck + 1 < SEQ / 256) {
#pragma unroll
                for (int i = 0; i < 4; ++i) { const bf16* src = zx + (size_t)((ck + 1) * 256 + rq + 8 * i) * DZ; px[i] = *(const v4u*)src; pg[i] = *(const v4u*)(src + DLRU); }
                if (lane < 24) ph = *(const v4u*)(zx + ((long)(ck + 1) * 256 + rq - 3) * DZ); }
            { const int cg = lane & 7;
              f32x4 cw[5][2];
#pragma unroll
              for (int k = 0; k < 5; ++k) { const LAS f32x4* wp = (const LAS f32x4*)(lds + MX_CW + k * 64 * 4 + cg * 32); cw[k][0] = wp[0]; cw[k][1] = wp[1]; }
#pragma unroll
              for (int i = 0; i < 4; ++i) { const int tl = (lane >> 3) + 8 * i, r = 32 * w + tl;
                f32x4 a0 = cw[4][0], a1 = cw[4][1];
#pragma unroll
                for (int k = 0; k < 4; ++k) { const v4u x = *(const LAS v4u*)(xrw + (tl + k) * MX_STRIDE + cg * 16);
                    a0 += cw[k][0] * (f32x4){bflo(x[0]), bfhi(x[0]), bflo(x[1]), bfhi(x[1])}; a1 += cw[k][1] * (f32x4){bflo(x[2]), bfhi(x[2]), bflo(x[3]), bfhi(x[3])}; }
                v4u o; o.x = pk2(a0[0], a0[1]); o.y = pk2(a0[2], a0[3]); o.z = pk2(a1[0], a1[1]); o.w = pk2(a1[2], a1[3]);
                *(LAS v4u*)(lds + MX_CB + r * MX_STRIDE + cg * 16) = o; } }
            LDS_WAIT();
            const int arow = 32 * w + 8 * (fr >> 2) + (fr & 3);
            f32x4 ar[2][4], ai[2][4];
#pragma unroll
            for (int m = 0; m < 2; ++m) {
                bf16x8 Af[2];
#pragma unroll
                for (int ks = 0; ks < 2; ++ks) Af[ks] = *(const LAS bf16x8*)(lds + MX_CB + (arow + 4 * m) * MX_STRIDE + ks * 64 + fq * 16);
#pragma unroll
                for (int n = 0; n < 4; ++n) { f32x4 cr = (f32x4){cbr[n], cbr[n], cbr[n], cbr[n]}, ci = (f32x4){cbi[n], cbi[n], cbi[n], cbi[n]};
#pragma unroll
                    for (int ks = 0; ks < 2; ++ks) { const bf16x8 br = *(const LAS bf16x8*)(lds + MX_WT + (16 * n + fr) * MX_STRIDE + ks * 64 + fq * 16), bi = *(const LAS bf16x8*)(lds + MX_WT + (64 + 16 * n + fr) * MX_STRIDE + ks * 64 + fq * 16);
                        cr = __builtin_amdgcn_mfma_f32_16x16x32_bf16(Af[ks], br, cr, 0, 0, 0); ci = __builtin_amdgcn_mfma_f32_16x16x32_bf16(Af[ks], bi, ci, 0, 0, 0); }
                    const f32x4 cbt = __builtin_amdgcn_mfma_f32_16x16x32_bf16(Af[n >> 1], Iden[n & 1], (f32x4){0.f, 0.f, 0.f, 0.f}, 0, 0, 0);
                    float A[4], B[4];
#pragma unroll
                    for (int j = 0; j < 4; ++j) {
                        const float rg = __builtin_amdgcn_rcpf(1.0f + __builtin_amdgcn_exp2f(cr[j]));
                        const float ig = __builtin_amdgcn_rcpf(1.0f + __builtin_amdgcn_exp2f(ci[j]));
                        const float a = __builtin_amdgcn_exp2f(rg * ck2[n]);
                        const float mult = __builtin_amdgcn_sqrtf(1.0f - a * a);
                        const float uu = mult * ig * cbt[j];
                        if (j == 0) { if (m == 0) { A[0] = a; B[0] = uu; } else { A[0] = a * ar[0][n][3]; B[0] = a * ai[0][n][3] + uu; } }
                        else { A[j] = a * A[j - 1]; B[j] = a * B[j - 1] + uu; }
                    }
                    ar[m][n] = (f32x4){A[0], A[1], A[2], A[3]}; ai[m][n] = (f32x4){B[0], B[1], B[2], B[3]};
                } }
            float TA[4], TB[4], XA[4], XB_[4];
#pragma unroll
            for (int n = 0; n < 4; ++n) {
                float Ag_ = ar[1][n][3], Bg_ = ai[1][n][3];
                { const float Ap = lane_even(Ag_), Bp = lane_even(Bg_); if (fq & 1) { Bg_ = Ag_ * Bp + Bg_; Ag_ = Ap * Ag_; } }
                const float PA = lane_row1(Ag_), PB = lane_row1(Bg_);
                if (fq >= 2) { Bg_ = Ag_ * PB + Bg_; Ag_ = PA * Ag_; }
                float Ax = lane_even(Ag_), Bx = lane_even(Bg_);
                if (fq == 2) { Ax = PA; Bx = PB; }
                if (fq == 0) { Ax = 1.0f; Bx = 0.0f; }
                TA[n] = lane_row3(Ag_); TB[n] = lane_row3(Bg_);
                XA[n] = Ax; XB_[n] = Bx;
            }
            if (fq == 0) {
#pragma unroll
                for (int n = 0; n < 4; ++n)
                    *(LAS f32x2*)(lds + MX_TOT + (ck & 1) * 4096 + ((w * 64) + 16 * n + fr) * 8) = (f32x2){TA[n], TB[n]}; }
            LDS_SYNC();
            float EL[4];
#pragma unroll
            for (int n = 0; n < 4; ++n) { float st = Hs[n], mine = 0.f;
#pragma unroll
                for (int v = 0; v < 8; ++v) { if (v == w) mine = st; const f32x2 ab = *(const LAS f32x2*)(lds + MX_TOT + (ck & 1) * 4096 + ((v * 64) + 16 * n + fr) * 8); st = ab.x * st + ab.y; }
                Hs[n] = st; EL[n] = XA[n] * mine + XB_[n]; }
#pragma unroll
            for (int m = 0; m < 2; ++m) {
                f32x4 gt[4];
                { bf16x8 Ag[2];
#pragma unroll
                  for (int ks = 0; ks < 2; ++ks) Ag[ks] = *(const LAS bf16x8*)(lds + MX_GR + (arow + 4 * m) * MX_STRIDE + ks * 64 + fq * 16);
#pragma unroll
                  for (int n = 0; n < 4; ++n) gt[n] = __builtin_amdgcn_mfma_f32_16x16x32_bf16(Ag[n >> 1], Iden[n & 1], (f32x4){0.f, 0.f, 0.f, 0.f}, 0, 0, 0); }
#pragma unroll
                for (int j = 0; j < 4; ++j) {
                    const int tl = 8 * fq + 4 * m + j; float yv[4]; float ss = 0.f;
#pragma unroll
                    for (int n = 0; n < 4; ++n) {
                        const float hv = ar[m][n][j] * EL[n] + ai[m][n][j];
                        yv[n] = hv * gt[n][j]; ss += yv[n] * yv[n]; }
                    ss = row_sum16(ss);
                    const float sc = __builtin_amdgcn_rsqf(ss * (1.0f / 64.0f) + EPS);
#pragma unroll
                    for (int n = 0; n < 4; ++n) { const float yo = yv[n] * sc; *(LAS unsigned short*)(lds + MX_CB + (32 * w + tl) * MX_STRIDE + (16 * n + fr) * 2) = (unsigned short)pk2(yo, yo); }
                } }
            LDS_WAIT();
#pragma unroll
            for (int i = 0; i < 4; ++i) { const int item = lane + 64 * i, tl = item >> 3, cg = item & 7, r = 32 * w + tl;
                *(v4u*)(y + (size_t)(tok0 + r) * D + DCONV + hh * HD + 8 * cg) = *(const LAS v4u*)(lds + MX_CB + r * MX_STRIDE + cg * 16); }
        }
    }
}

#define RT_STEP(v_, i_, ctrl_) do { const float ov_ = __builtin_bit_cast(float, __builtin_amdgcn_update_dpp(0, __builtin_bit_cast(int, v_), ctrl_, 0xF, 0xF, false)); \
        const int oi_ = __builtin_amdgcn_update_dpp(0, i_, ctrl_, 0xF, 0xF, false); if (ov_ > v_ || (ov_ == v_ && oi_ < i_)) { v_ = ov_; i_ = oi_; } } while (0)
__device__ __forceinline__ void rt_phase(Frame& F, int j) {
    const bf16* h = (const bf16*)(F.ws + WS_HB); const float* gwr = (const float*)(F.ws + WS_GWR) + (size_t)j * D * NE;
    int* tokE = (int*)(F.ws + WS_TOKE); int* tokR = (int*)(F.ws + WS_TOKR); float* tokG = (float*)(F.ws + WS_TOKG); unsigned char* xb = F.ws + WS_XB8S;
    unsigned* gcnt = F.ctl + CW_GCNT + j * 8 * 64;
    LAS int* lcnt = (LAS int*)(F.lds + 0); LAS int* lbase = (LAS int*)(F.lds + 64);
    LAS int* sE = (LAS int*)(F.lds + 1024); LAS int* sR = (LAS int*)(F.lds + 2048); LAS float* sG = (LAS float*)(F.lds + 3072); LAS float* sRS = (LAS float*)(F.lds + 4096);
    constexpr int STR = 2080;
    LAS unsigned char* img = F.lds + 8192;
    const int lane = F.lane, w = F.wave, fr = lane & 15, fq = lane >> 4, tid = F.tid;
    __syncthreads();
    for (int p = tid; p < D * NE; p += NWAVES * 64) { const int d = p >> 3, e = p & 7; const float g = gwr[p];
        const unsigned hi = f2bf(g); const float ghi = __builtin_bit_cast(float, hi << 16); const unsigned lo = f2bf(g - ghi);
        *(LAS unsigned short*)(img + e * STR + d * 2) = (unsigned short)hi; *(LAS unsigned short*)(img + (8 + e) * STR + d * 2) = (unsigned short)lo; }
    for (int tile = F.vcu; tile < T / 128; tile += F.G) {
        __syncthreads();
        if (tid < 8) lcnt[tid] = 0;
        __syncthreads();
        const int tlo = w * 16 + fr;
        const bf16* hrow = h + (size_t)(tile * 128 + tlo) * D + 8 * fq;
        v4u A[2][8];
#pragma unroll
        for (int k8 = 0; k8 < 8; ++k8) A[0][k8] = *(const v4u*)(hrow + 32 * k8);
        f32x4 acc = (f32x4){0.f, 0.f, 0.f, 0.f}; float ssl = 0.f;
#pragma unroll
        for (int c = 0; c < 4; ++c) {
            if (c + 1 < 4) {
#pragma unroll
                for (int k8 = 0; k8 < 8; ++k8) A[(c + 1) & 1][k8] = *(const v4u*)(hrow + 32 * (8 * (c + 1) + k8)); }
#pragma unroll
            for (int k8 = 0; k8 < 8; ++k8) { const int ks = 8 * c + k8; const v4u a = A[c & 1][k8];
                const bf16x8 bfrag = *(const LAS bf16x8*)(img + fr * STR + (32 * ks + 8 * fq) * 2);
                acc = __builtin_amdgcn_mfma_f32_16x16x32_bf16(__builtin_bit_cast(bf16x8, a), bfrag, acc, 0, 0, 0);
#pragma unroll
                for (int q = 0; q < 4; ++q) { const unsigned u = a[q]; const float lo = bflo(u), hi = bfhi(u); ssl += lo * lo + hi * hi; } }
            __builtin_amdgcn_sched_barrier(0);
        }
        ssl += __shfl_xor(ssl, 16); ssl += __shfl_xor(ssl, 32);
        const float rso = __builtin_amdgcn_rsqf(ssl * (1.0f / 1024.0f) + EPS);
        if (fq == 0) sRS[tlo] = rso;
#pragma unroll
        for (int jj = 0; jj < 4; ++jj) {
            float v = acc[jj] + __shfl_down(acc[jj], 8);
            if (fr >= 8) v = -3.0e38f;
            float bv = v; int bi = fr;
            RT_STEP(bv, bi, 0xB1); RT_STEP(bv, bi, 0x4E); RT_STEP(bv, bi, 0x141);
            float sv = (fr == bi) ? -3.0e38f : v; int si = fr;
            RT_STEP(sv, si, 0xB1); RT_STEP(sv, si, 0x4E); RT_STEP(sv, si, 0x141);
            if (fr == 0) { const int tl = w * 16 + 4 * fq + jj; const float rs = sRS[tl];
                const float ex = __expf((sv - bv) * rs); const float g0 = 1.0f / (1.0f + ex), g1 = ex / (1.0f + ex);
                const int r0 = __hip_atomic_fetch_add(lcnt + bi, 1, __ATOMIC_RELAXED, __HIP_MEMORY_SCOPE_WORKGROUP), r1 = __hip_atomic_fetch_add(lcnt + si, 1, __ATOMIC_RELAXED, __HIP_MEMORY_SCOPE_WORKGROUP);
                sE[2 * tl] = bi; sE[2 * tl + 1] = si; sR[2 * tl] = r0; sR[2 * tl + 1] = r1; sG[2 * tl] = g0; sG[2 * tl + 1] = g1; }
        }
        __syncthreads();
        if (tid < 8) lbase[tid] = (int)__hip_atomic_fetch_add(gcnt + tid * 64, (unsigned)lcnt[tid], RLX_AGENT);
        __syncthreads();
        if (tid < 128) { const int t = tile * 128 + tid;
#pragma unroll
            for (int k = 0; k < 2; ++k) { const int e = sE[2 * tid + k]; tokE[2 * t + k] = e; tokR[2 * t + k] = lbase[e] + sR[2 * tid + k]; tokG[2 * t + k] = sG[2 * tid + k]; } }
#pragma unroll 4
        for (int tt = 0; tt < 16; ++tt) {
            const int tl = w * 16 + tt, t = tile * 128 + tl;
            const float rs = sRS[tl] * 16.0f;
            const int e0 = sE[2 * tl], e1 = sE[2 * tl + 1];
            const size_t p0 = (size_t)e0 * T + (size_t)(lbase[e0] + sR[2 * tl]), p1 = (size_t)e1 * T + (size_t)(lbase[e1] + sR[2 * tl + 1]);
#pragma unroll
            for (int i = 0; i < 2; ++i) { const v4u hw = *(const v4u*)(h + (size_t)t * D + 8 * lane + 512 * i);
                v2u w8; w8.x = pg8::pk4_fp8(bflo(hw.x) * rs, bfhi(hw.x) * rs, bflo(hw.y) * rs, bfhi(hw.y) * rs); w8.y = pg8::pk4_fp8(bflo(hw.z) * rs, bfhi(hw.z) * rs, bflo(hw.w) * rs, bfhi(hw.w) * rs);
                *(v2u*)(xb + p0 * D + 8 * lane + 512 * i) = w8; *(v2u*)(xb + p1 * D + 8 * lane + 512 * i) = w8; }
        }
    }
}
__device__ __forceinline__ void expert_tiles(Frame& F, int j, int (&tend)[8]) {
    const unsigned* gcnt = F.ctl + CW_GCNT + j * 8 * 64; int acc = 0;
#pragma unroll
    for (int e = 0; e < 8; ++e) { const int c = (int)__builtin_amdgcn_readfirstlane((int)gcnt[e * 64]); acc += (c + 255) >> 8; tend[e] = acc; }
}
__device__ __forceinline__ void cb_phase(Frame& F, int j, int s_next, int part, int lim, int gw, int NGW) {
    bf16* hb = (bf16*)(F.ws + WS_HB); const bf16* ys = (const bf16*)(F.ws + WS_XB); float* out = F.out;
    const int* tokE = (const int*)(F.ws + WS_TOKE); const int* tokR = (const int*)(F.ws + WS_TOKR); const float* tokG = (const float*)(F.ws + WS_TOKG);
    pg8::u64* sumsq = (pg8::u64*)(F.ws + WS_SUMSQ) + (size_t)s_next * T;
    const bool last = (j == 1);
    LAS int* tstart = (LAS int*)(F.lds + 0);
    { int tend[8]; expert_tiles(F, j, tend);
      __syncthreads();
      if (F.tid == 0) { tstart[0] = 0;
#pragma unroll
          for (int e = 1; e < 8; ++e) tstart[e] = tend[e - 1]; }
      __syncthreads(); }
    const int lane = F.lane;
    f32x4 fg[2][2];
#pragma unroll
    for (int i = 0; i < 2; ++i) { const f32x4* fp = (const f32x4*)(F.in[I_FG] + 8 * lane + 512 * i); fg[i][0] = fp[0]; fg[i][1] = fp[1]; }
    for (int tb = gw; tb < T; tb += 2 * NGW) {
        v4u hw[2][2], ya[2][2], yb[2][2]; float g0[2], g1[2]; bool ok[2];
#pragma unroll
        for (int u = 0; u < 2; ++u) { const int t = tb + u * NGW; ok[u] = t < T; const int tt = ok[u] ? t : tb;
            const int p0 = tstart[tokE[2 * tt]] * 256 + tokR[2 * tt], p1 = tstart[tokE[2 * tt + 1]] * 256 + tokR[2 * tt + 1]; g0[u] = tokG[2 * tt]; g1[u] = tokG[2 * tt + 1];
            if (part) { const bool low = (p0 < lim) && (p1 < lim); ok[u] = ok[u] && (part == 1 ? low : !low); }
#pragma unroll
            for (int i = 0; i < 2; ++i) { hw[u][i] = (v4u){0u, 0u, 0u, 0u}; ya[u][i] = (v4u){0u, 0u, 0u, 0u}; yb[u][i] = (v4u){0u, 0u, 0u, 0u}; }
            if (ok[u]) {
#pragma unroll
                for (int i = 0; i < 2; ++i) { hw[u][i] = *(const v4u*)(hb + (size_t)tt * D + 8 * lane + 512 * i); ya[u][i] = *(const v4u*)(ys + (size_t)p0 * D + 8 * lane + 512 * i); yb[u][i] = *(const v4u*)(ys + (size_t)p1 * D + 8 * lane + 512 * i); } } }
#pragma unroll
        for (int u = 0; u < 2; ++u) { const int t = tb + u * NGW;
            float x[2][8]; float ss = 0.f;
#pragma unroll
            for (int i = 0; i < 2; ++i)
#pragma unroll
                for (int q = 0; q < 4; ++q) { const unsigned h_ = hw[u][i][q], a_ = ya[u][i][q], b_ = yb[u][i][q];
                    const float lo = bflo(h_) + g0[u] * bflo(a_) + g1[u] * bflo(b_), hi = bfhi(h_) + g0[u] * bfhi(a_) + g1[u] * bfhi(b_);
                    x[i][2 * q] = lo; x[i][2 * q + 1] = hi; ss += lo * lo + hi * hi; }
            ss = wave_sum(ss);
            if (ok[u]) {
                if (!last) {
#pragma unroll
                    for (int i = 0; i < 2; ++i) { v4u w; w.x = pk2(x[i][0], x[i][1]); w.y = pk2(x[i][2], x[i][3]); w.z = pk2(x[i][4], x[i][5]); w.w = pk2(x[i][6], x[i][7]);
                        *(v4u*)(hb + (size_t)t * D + 8 * lane + 512 * i) = w; }
                    if (lane == 0) sumsq[t] = pg8::ss_to_fx(ss);
                } else {
                    const float rs = __builtin_amdgcn_rsqf(ss * (1.0f / 1024.0f) + EPS);
#pragma unroll
                    for (int i = 0; i < 2; ++i) { f32x4* orow = (f32x4*)(out + (size_t)t * D + 8 * lane + 512 * i);
                        orow[0] = (f32x4){x[i][0], x[i][1], x[i][2], x[i][3]} * rs * fg[i][0]; orow[1] = (f32x4){x[i][4], x[i][5], x[i][6], x[i][7]} * rs * fg[i][1]; }
                }
            }
        }
    }
}

struct Args { const float* in[23]; float* out; unsigned char* ws; int ph_lo, ph_hi, rep_mask, pad; };
__global__ void __launch_bounds__(NWAVES * 64, 2) hymba_fwd(Args args) {
    extern __shared__ __attribute__((aligned(16))) unsigned char lds[];
#define MKFRAME() Frame F; { int t_ = threadIdx.x, bx_ = blockIdx.x, g_ = gridDim.x; asm volatile("" : "+v"(t_)); asm volatile("" : "+s"(bx_)); asm volatile("" : "+s"(g_)); \
        F.lds = (LAS unsigned char*)lds; F.MISC = (volatile LAS unsigned*)(F.lds + MISC_OFF); F.tid = t_; F.lane = t_ & 63; F.wave = __builtin_amdgcn_readfirstlane(t_ >> 6); \
        F.G = g_; F.bx = bx_; F.vcu = (g_ % 8 == 0) ? (bx_ % 8) * (g_ / 8) + bx_ / 8 : bx_; F.ws = args.ws; F.ctl = (unsigned*)(args.ws + WS_CTL); F.out = args.out; F.in = args.in; }
    { MKFRAME();
      for (int u = F.tid; u < (LDS_BYTES - LDSCTL_OFF) / 4; u += NWAVES * 64) ((LAS unsigned*)(F.lds + LDSCTL_OFF))[u] = 0u; }
    __syncthreads();
    const bool one_launch = (args.ph_hi - args.ph_lo) > 1;
    XcdBarrier bar; bar.bar = (unsigned*)(args.ws + WS_CTL) + CW_BAR; bar.x = 0; bar.st = nullptr;
    if (one_launch) bar = xcd_barrier_post((unsigned*)(args.ws + WS_CTL) + CW_BAR, (volatile LAS unsigned*)((LAS unsigned char*)lds + MISC_OFF) + 8);
    const int lo = args.ph_lo, hi = args.ph_hi;
#define IN(k) (lo <= (k) && (k) < hi)
#if REP_MASK
#define REPS(b) for (int rep_ = 0; rep_ <= ((args.rep_mask >> (b)) & 1); ++rep_)
#else
#define REPS(b)
#endif
#define SEAM(k) do { if (IN((k) + 1)) xcd_barrier(bar); } while (0)

    if (DBG_ON(0) && IN(0)) { REPS(0) { MKFRAME(); p0_prologue(F); } SEAM(0); }

    for (int l = 0; l < DEPTH; ++l) {
        const int pb = 1 + (l >> 1) * 13 + (l & 1) * 5, j = l >> 1;
        if (DBG_ON(1) && IN(pb + 0)) { REPS(1) { MKFRAME(); pg8::u64* sumsq = (pg8::u64*)(F.ws + WS_SUMSQ); bf16* hb = (bf16*)(F.ws + WS_HB);
            pg8::Gemm g{hb, (const bf16*)(F.ws + WS_WIN) + (size_t)l * DIN * D, 2 * D, 0, 0}; pg8::Sched S; S.init(T / 256, DIN / 256, F.G, F.bx);
            pg8::EpiMix E{(bf16*)(F.ws + WS_Z), DZ, sumsq + (size_t)(2 * l) * T};
            pg8::gemm_phase<pg8::EpiMix, false, false>(F.lds + RING_OFF, g, S, E, F.tid); }
            SEAM(pb + 0);
        }
        if (DBG_ON(2) && IN(pb + 1)) { REPS(2) { MKFRAME();
            const int bx = F.bx;
            int role, idx, n;
            if (F.G >= 16 && (F.G % 16) == 0) { role = (bx >> 3) & 1; idx = (bx >> 4) * 8 + (bx & 7); n = F.G / 2; }
            else if (F.G >= 2) { role = bx & 1; idx = bx >> 1; n = role ? F.G / 2 : (F.G + 1) / 2; }
            else { role = 2; idx = 0; n = 1; }
            if (role != 1) mix_lru(F, l, idx, n);
            if (role != 0) { mix_conv_a(F, l, idx, n);
                const int half = (NE - P0_EXPERTS) / 2, e_lo = P0_EXPERTS + (l & 1) * half, e_hi = (l & 1) ? NE : e_lo + half; int rot = 0;
                convert_experts_pipe(F, l >> 1, e_lo, e_hi, idx * NWAVES + F.wave, n * NWAVES); } }
            SEAM(pb + 1);
        }
        if (DBG_ON(3) && IN(pb + 2)) { { MKFRAME(); pg8::u64* sumsq = (pg8::u64*)(F.ws + WS_SUMSQ); bf16* hb = (bf16*)(F.ws + WS_HB);
            pg8::Gemm g{(const bf16*)(F.ws + WS_Y), (const bf16*)(F.ws + WS_WOUT) + (size_t)l * D * D, 2 * D, 0, 0}; pg8::Sched S; S.init(T / 256, D / 256, F.G, F.bx);
            pg8::EpiResid E{hb, sumsq + (size_t)(2 * l + 1) * T, (l & 1) ? 0 : 2, F.ws + WS_XB};
            pg8::gemm_phase<pg8::EpiResid, false, false>(F.lds + RING_OFF, g, S, E, F.tid); }
            SEAM(pb + 2);
        }
        if ((l & 1) == 0) {
            if (DBG_ON(4) && IN(pb + 3)) { REPS(4) { MKFRAME(); pg8::u64* sumsq = (pg8::u64*)(F.ws + WS_SUMSQ);
                pg8::Gemm g{F.ws + WS_XB, F.ws + WS_W13 + (size_t)j * (2 * FF) * D, D, 0x7C7C7C7C, 0x79797979}; pg8::Sched S; S.init(T / 256, (2 * FF) / 256, F.G, F.bx);
                pg8::EpiSwiglu8 E{F.ws + WS_U, FF, sumsq + (size_t)(2 * l + 1) * T};
                pg8::gemm_phase<pg8::EpiSwiglu8, false, true>(F.lds + RING_OFF, g, S, E, F.tid); }
                SEAM(pb + 3);
            }
            if (DBG_ON(5) && IN(pb + 4)) { { MKFRAME(); pg8::u64* sumsq = (pg8::u64*)(F.ws + WS_SUMSQ); bf16* hb = (bf16*)(F.ws + WS_HB);
                pg8::Gemm g{F.ws + WS_U, F.ws + WS_W2 + (size_t)j * D * FF, FF, 0x7D7D7D7D, 0x78787878}; pg8::Sched S; S.init(T / 256, D / 256, F.G, F.bx);
                pg8::EpiResid E{hb, sumsq + (size_t)(2 * l + 2) * T, 1, nullptr};
                pg8::gemm_phase<pg8::EpiResid, false, true>(F.lds + RING_OFF, g, S, E, F.tid); }
                SEAM(pb + 4);
            }
        } else {
            if (DBG_ON(6) && IN(pb + 3)) { { MKFRAME(); rt_phase(F, j); } SEAM(pb + 3); }
            if (DBG_ON(8) && IN(pb + 4)) { REPS(8) { MKFRAME();
                pg8::Sched S; { int tend[8]; expert_tiles(F, j, tend); S.init(tend[7], (2 * FFE) / 256, F.G, F.bx);
#pragma unroll
                    for (int e = 0; e < 8; ++e) S.tend[e] = tend[e]; S.estride = (size_t)(2 * FFE) * D; S.ecap = T; }
                pg8::Gemm g{F.ws + WS_XB8S, F.ws + WS_WE13 + (size_t)j * NE * (2 * FFE) * D, D, 0x7B7B7B7B  , 0x79797979  };
                pg8::EpiSwiglu8 E{F.ws + WS_HID, FFE, nullptr};
                pg8::gemm_phase<pg8::EpiSwiglu8, true, true, true>(F.lds + RING_OFF, g, S, E, F.tid); }
                SEAM(pb + 4);
            }
            if (DBG_ON(9) && IN(pb + 5)) { REPS(9) { MKFRAME();
                pg8::Sched S; { int tend[8]; expert_tiles(F, j, tend); S.init(tend[7] < F.G ? tend[7] : F.G, D / 256, F.G, F.bx);
#pragma unroll
                    for (int e = 0; e < 8; ++e) S.tend[e] = tend[e]; S.estride = (size_t)D * FFE; }
                pg8::Gemm g{F.ws + WS_HID, F.ws + WS_WE2 + (size_t)j * NE * D * FFE, FFE, 0x7D7D7D7D  , 0x78787878  };
                pg8::EpiScale E{(bf16*)(F.ws + WS_XB), D, nullptr};
                pg8::gemm_phase<pg8::EpiScale, true, true>(F.lds + RING_OFF, g, S, E, F.tid); }
                SEAM(pb + 5);
            }
            if (DBG_ON(10) && IN(pb + 6)) { { MKFRAME();
                int tend[8]; expert_tiles(F, j, tend);
                const int nM = tend[7], nL = nM > F.G ? nM - F.G : 0, NT = 32;
                if (nL > 0 && F.G > 2 * NT) {
                    if (F.bx < NT) {
                        pg8::Sched S; S.init(nL, D / 256, NT, F.bx);
#pragma unroll
                        for (int e = 0; e < 8; ++e) S.tend[e] = tend[e];
                        S.estride = (size_t)D * FFE; S.pm0 = F.G;
                        pg8::Gemm g{F.ws + WS_HID, F.ws + WS_WE2 + (size_t)j * NE * D * FFE, FFE, 0x7D7D7D7D, 0x78787878};
                        pg8::EpiScale E{(bf16*)(F.ws + WS_XB), D, nullptr};
                        pg8::gemm_phase<pg8::EpiScale, true, true>(F.lds + RING_OFF, g, S, E, F.tid);
                    } else cb_phase(F, j, 2 * l + 2, 1, F.G * 256, (F.bx - NT) * NWAVES + F.wave, (F.G - NT) * NWAVES);
                } else cb_phase(F, j, 2 * l + 2, 0, 0, F.vcu * NWAVES + F.wave, F.G * NWAVES);
                }
                SEAM(pb + 6);
            }
            if (DBG_ON(10) && IN(pb + 7)) { { MKFRAME();
                int tend[8]; expert_tiles(F, j, tend);
                if (tend[7] > F.G && F.G > 64) cb_phase(F, j, 2 * l + 2, 2, F.G * 256, (F.bx >= 32 ? (F.bx - 32) : (F.G - 32 + F.bx)) * NWAVES + F.wave, F.G * NWAVES);
                }
                SEAM(pb + 7);
            }
        }
    }
#undef IN
#undef SEAM
}

extern "C" void kernel_launch(void* const* d_in, const int* in_sizes, int n_in, void* d_out, int out_size, void* d_ws, size_t ws_size, hipStream_t stream) {
    static int grid = 0;
    if (grid == 0) {
        if (n_in != 23 || in_sizes[0] != T * D || out_size != T * D || ws_size < WS_END) {
            fprintf(stderr, "kernel_launch: built for 23 inputs, x/out of %d floats, >= %zu bytes of workspace; got n_in %d, in0 %d, out %d, ws %zu; nothing launched\n", T * D, (size_t)WS_END, n_in, n_in > 0 ? in_sizes[0] : -1, out_size, ws_size);
            grid = -1; return; }
        int dev = 0, cus = 0, per_cu = 0;
        if (hipGetDevice(&dev) != hipSuccess || hipDeviceGetAttribute(&cus, hipDeviceAttributeMultiprocessorCount, dev) != hipSuccess) { fprintf(stderr, "kernel_launch: device query failed\n"); grid = -1; return; }
        if (hipFuncSetAttribute((const void*)hymba_fwd, hipFuncAttributeMaxDynamicSharedMemorySize, LDS_BYTES) != hipSuccess) { fprintf(stderr, "kernel_launch: hipFuncSetAttribute failed\n"); grid = -1; return; }
        if (hipOccupancyMaxActiveBlocksPerMultiprocessor(&per_cu, (const void*)hymba_fwd, NWAVES * 64, LDS_BYTES) != hipSuccess || per_cu < 1)
            fprintf(stderr, "kernel_launch: note: occupancy query reports %d workgroups per CU\n", per_cu);
        (void)hipGetLastError();
        grid = cus;
    }
    if (grid < 0) return;
    if (hipMemsetAsync((char*)d_ws + WS_CTL, 0, CTL_ZERO_BYTES, stream) != hipSuccess) { fprintf(stderr, "kernel_launch: memset failed\n"); return; }
    Args a{};
    for (int i = 0; i < 23; ++i) a.in[i] = (const float*)d_in[i];
    a.out = (float*)d_out; a.ws = (unsigned char*)d_ws; a.rep_mask = REP_MASK;
#if MK_MULTI
    for (int p = 0; p < NPHASE; ++p) { a.ph_lo = p; a.ph_hi = p + 1; hipLaunchKernelGGL(hymba_fwd, dim3(grid), dim3(NWAVES * 64), LDS_BYTES, stream, a); }
#else
    a.ph_lo = 0; a.ph_hi = NPHASE;
    hipLaunchKernelGGL(hymba_fwd, dim3(grid), dim3(NWAVES * 64), LDS_BYTES, stream, a);
#endif
    const hipError_t le = hipPeekAtLastError();
    if (le != hipSuccess) fprintf(stderr, "kernel_launch: launch failed: %s\n", hipGetErrorName(le));
}
```
